# Optimizing an MI355X kernel written in HIP

```python
import math
import jax, jax.numpy as jnp
from jax import lax
import numpy as np

D_MODEL = 1024
BATCH = 4
SEQ = 4096
DEPTH = 1

HEAD_DIM = 64
N_HEADS_FOX = 8
N_HEADS_DIL = 8
FOX_WIDTH = N_HEADS_FOX * HEAD_DIM
DIL_WIDTH = N_HEADS_DIL * HEAD_DIM
DIL_PATTERNS = ((128, 1), (512, 4), (2048, 16))
ROPE_DIM = HEAD_DIM // 4
ROPE_THETA = 500000.0
Q_BLOCK = 128
D_FF = 2816
CONV_WIDTH = 3
RMS_EPS = 1e-6
NEG_INF = -1e30
IN_SPLITS = (FOX_WIDTH, FOX_WIDTH, FOX_WIDTH, N_HEADS_FOX,
             DIL_WIDTH, DIL_WIDTH, DIL_WIDTH, D_MODEL, D_MODEL)
IN_WIDTH = sum(IN_SPLITS)

kernel_name = "hybrid_fox_dilated_gated_convffn"


def rmsnorm(x, g):
    xf = x.astype(jnp.float32)
    inv = lax.rsqrt(jnp.mean(xf * xf, axis=-1, keepdims=True) + RMS_EPS)
    return (xf * inv * g.astype(jnp.float32)).astype(x.dtype)


def partial_rope(t):
    S = t.shape[1]
    half = ROPE_DIM // 2
    inv_freq = ROPE_THETA ** (-jnp.arange(half, dtype=jnp.float32) * 2.0 / ROPE_DIM)
    ang = jnp.arange(S, dtype=jnp.float32)[:, None] * inv_freq[None, :]
    cos = jnp.cos(ang)[:, None, :]
    sin = jnp.sin(ang)[:, None, :]
    tf = t.astype(jnp.float32)
    t1, t2, rest = tf[..., :half], tf[..., half:ROPE_DIM], tf[..., ROPE_DIM:]
    out = jnp.concatenate([t1 * cos - t2 * sin, t2 * cos + t1 * sin, rest], axis=-1)
    return out.astype(t.dtype)


def split_heads(t, n_heads):
    B, S, _ = t.shape
    return t.reshape(B, S, n_heads, HEAD_DIM)


def fox_attention(q, k, v, log_f):
    B, S, H, dh = q.shape
    nb = S // Q_BLOCK
    scale = 1.0 / math.sqrt(dh)
    F = jnp.cumsum(log_f, axis=1).transpose(0, 2, 1)
    kt = k.transpose(0, 2, 1, 3)
    vt = v.transpose(0, 2, 1, 3)
    q_blocks = q.transpose(0, 2, 1, 3).reshape(B, H, nb, Q_BLOCK, dh).transpose(2, 0, 1, 3, 4)
    f_blocks = F.reshape(B, H, nb, Q_BLOCK).transpose(2, 0, 1, 3)
    starts = jnp.arange(nb, dtype=jnp.int32) * Q_BLOCK
    kpos = jnp.arange(S, dtype=jnp.int32)

    def one_block(args):
        qb, fqb, start = args
        s = jnp.einsum('bhqd,bhkd->bhqk', qb, kt).astype(jnp.float32) * scale
        s = s + fqb[..., None] - F[:, :, None, :]
        qpos = start + jnp.arange(Q_BLOCK, dtype=jnp.int32)
        causal = kpos[None, :] <= qpos[:, None]
        s = jnp.where(causal[None, None], s, NEG_INF)
        p = jax.nn.softmax(s, axis=-1)
        return jnp.einsum('bhqk,bhkd->bhqd', p.astype(vt.dtype), vt)

    out = lax.map(one_block, (q_blocks, f_blocks, starts))
    return out.transpose(1, 0, 3, 2, 4).reshape(B, S, H, dh)


def dilated_branch(q, k, v, window, dilation):
    B, S, H, dh = q.shape
    L = S // dilation
    w_sub = window // dilation
    blk = w_sub
    nb = -(-L // blk)
    Lp = nb * blk
    scale = 1.0 / math.sqrt(dh)

    def prep(t):
        t = t.reshape(B, L, dilation, H, dh)
        t = jnp.pad(t, ((0, 0), (0, Lp - L), (0, 0), (0, 0), (0, 0)))
        return t.reshape(B, nb, blk, dilation, H, dh)

    def with_prev(t):
        prev = jnp.pad(t[:, :-1], ((0, 0), (1, 0), (0, 0), (0, 0), (0, 0), (0, 0)))
        return jnp.concatenate([prev, t], axis=2)

    qs = prep(q)
    kk = with_prev(prep(k))
    vv = with_prev(prep(v))
    s = jnp.einsum('bnqrhd,bnkrhd->bnrhqk', qs, kk).astype(jnp.float32) * scale
    qi = jnp.arange(blk)[:, None]
    ki = jnp.arange(2 * blk)[None, :]
    dist = qi + blk - ki
    band = (dist >= 0) & (dist <= w_sub)
    exists = (jnp.arange(nb)[:, None, None] > 0) | (ki[None] >= blk)
    valid = band[None] & exists
    s = jnp.where(valid[None, :, None, None], s, NEG_INF)
    lse = jax.nn.logsumexp(s, axis=-1)
    p = jnp.exp(s - lse[..., None])
    o = jnp.einsum('bnrhqk,bnkrhd->bnqrhd', p.astype(vv.dtype), vv)
    o = o.reshape(B, Lp, dilation, H, dh)[:, :L].reshape(B, S, H, dh)
    lse = lse.transpose(0, 1, 4, 2, 3).reshape(B, Lp, dilation, H)[:, :L].reshape(B, S, H)
    return o, lse


def dilated_attention(q, k, v):
    outs, lses = [], []
    for window, dilation in DIL_PATTERNS:
        o, l = dilated_branch(q, k, v, window, dilation)
        outs.append(o)
        lses.append(l)
    lse = jnp.stack(lses, axis=0)
    alpha = jax.nn.softmax(lse, axis=0)
    out = jnp.stack(outs, axis=0).astype(jnp.float32)
    return jnp.sum(alpha[..., None] * out, axis=0).astype(q.dtype)


def causal_dwconv(u, w, b):
    S = u.shape[1]
    up = jnp.pad(u, ((0, 0), (CONV_WIDTH - 1, 0), (0, 0)))
    y = sum(up[:, i:i + S] * w[i] for i in range(CONV_WIDTH))
    return y + b


def setup_inputs(seed: int = 0) -> dict:
    key = jax.random.key(seed)
    ks = jax.random.split(key, 20)
    f32 = jnp.float32

    def nrm(k, shape, fan_in):
        return jax.random.normal(k, shape, f32) * (fan_in ** -0.5)

    def gain(k):
        return 1.0 + 0.05 * jax.random.normal(k, (DEPTH, D_MODEL), f32)

    return {
        "x": jax.random.normal(ks[0], (BATCH, SEQ, D_MODEL), f32),
        "g_pre_mix": gain(ks[1]),
        "w_in": nrm(ks[2], (DEPTH, D_MODEL, IN_WIDTH), D_MODEL),
        "b_forget": 2.0 + 0.5 * jax.random.normal(ks[3], (DEPTH, N_HEADS_FOX), f32),
        "w_o_fox": nrm(ks[4], (DEPTH, FOX_WIDTH, D_MODEL), FOX_WIDTH),
        "w_o_dil": nrm(ks[5], (DEPTH, DIL_WIDTH, D_MODEL), DIL_WIDTH),
        "w_out": nrm(ks[6], (DEPTH, D_MODEL, D_MODEL), D_MODEL),
        "g_post_mix": gain(ks[7]),
        "g_pre_ffn": gain(ks[8]),
        "w_up": nrm(ks[9], (DEPTH, D_MODEL, 2 * D_FF), D_MODEL),
        "conv_w": nrm(ks[10], (DEPTH, CONV_WIDTH, 2 * D_FF), CONV_WIDTH),
        "conv_b": 0.02 * jax.random.normal(ks[11], (DEPTH, 2 * D_FF), f32),
        "w_down": nrm(ks[12], (DEPTH, D_FF, D_MODEL), D_FF),
        "g_post_ffn": gain(ks[13]),
    }


def reference(x, g_pre_mix, w_in, b_forget, w_o_fox, w_o_dil, w_out, g_post_mix,
              g_pre_ffn, w_up, conv_w, conv_b, w_down, g_post_ffn):
    B, S, _ = x.shape
    offsets = np.cumsum((0,) + IN_SPLITS)
    for l in range(DEPTH):
        h = rmsnorm(x, g_pre_mix[l])
        z = h @ w_in[l]
        qa, ka, va, fa, qb, kb, vb, ga, gb = [z[..., offsets[i]:offsets[i + 1]]
                                              for i in range(len(IN_SPLITS))]
        log_f = jax.nn.log_sigmoid((fa + b_forget[l]).astype(jnp.float32))
        ya = fox_attention(split_heads(qa, N_HEADS_FOX), split_heads(ka, N_HEADS_FOX),
                           split_heads(va, N_HEADS_FOX), log_f)
        ya = ya.reshape(B, S, FOX_WIDTH) @ w_o_fox[l]
        qd = partial_rope(split_heads(qb, N_HEADS_DIL))
        kd = partial_rope(split_heads(kb, N_HEADS_DIL))
        yb = dilated_attention(qd, kd, split_heads(vb, N_HEADS_DIL))
        yb = yb.reshape(B, S, DIL_WIDTH) @ w_o_dil[l]
        mixed = jax.nn.sigmoid(ga) * ya + jax.nn.sigmoid(gb) * yb
        x = x + rmsnorm(mixed @ w_out[l], g_post_mix[l])
        h = rmsnorm(x, g_pre_ffn[l])
        u = causal_dwconv(h @ w_up[l], conv_w[l], conv_b[l])
        a, b = u[..., :D_FF], u[..., D_FF:]
        m = jax.nn.gelu(a, approximate=True) * b
        x = x + rmsnorm(m @ w_down[l], g_post_ffn[l])
    return x
```

```cpp
#include <hip/hip_runtime.h>
#include <hip/hip_cooperative_groups.h>
#include <cstdio>
#include <cstdint>
#include <cmath>
namespace cg = cooperative_groups;

#define LAS __attribute__((address_space(3)))
#define GAS __attribute__((address_space(1)))
typedef unsigned short bf16;
typedef short bf16x8 __attribute__((ext_vector_type(8)));
typedef float f32x2 __attribute__((ext_vector_type(2)));
typedef float f32x4 __attribute__((ext_vector_type(4)));
typedef float f32x16 __attribute__((ext_vector_type(16)));
typedef unsigned u32x2 __attribute__((ext_vector_type(2)));
typedef unsigned u32x4 __attribute__((ext_vector_type(4)));
typedef __bf16 bf16x2_t __attribute__((ext_vector_type(2)));

constexpr int NB = 4, SEQ = 4096, T = NB * SEQ, D = 1024, NH = 8, HD = 64;
constexpr int NZ = 5120;
constexpr int INW = 5128;
constexpr int FF = 2816, NUP = 2 * FF;
constexpr int NWAVES = 8, NTHR = NWAVES * 64;
constexpr float RMS_EPS = 1e-6f;
constexpr float LOG2E = 1.4426950408889634f;
constexpr float QSCALE = 0.125f * LOG2E;
constexpr float NEGBIG = -1e30f;

constexpr size_t MiB = 1u << 20;
constexpr size_t WS_BAR = 0, WS_CNT = 0x10000, WS_BAR_BYTES = 0x20000;
constexpr size_t WS_KH = 0x1C000, WS_FQ = 0x1D000;
constexpr size_t WS_MC = 0x1E000;
constexpr size_t WS_XBUF = 0x300000;
constexpr size_t WS_COS = 0x20000, WS_SIN = 0x40000, WS_LOGF = 0x80000, WS_F = 0x100000, WS_LSE = 0x180000;
constexpr size_t WS_WIN = 4 * MiB, WS_WO = 14 * MiB, WS_WOUT = 16 * MiB, WS_WUP = 18 * MiB, WS_WDN = 29 * MiB;
constexpr size_t WS_QKV = 36 * MiB;
constexpr size_t WS_SGA = 132 * MiB, WS_SGB = 164 * MiB;
constexpr size_t WS_H = 196 * MiB;
constexpr size_t WS_OD = 196 * MiB;
constexpr size_t WS_O2 = 84 * MiB;
constexpr size_t WS_MIXED = 36 * MiB;
constexpr size_t WS_H2 = 198 * MiB;
constexpr size_t WS_M = 100 * MiB;
constexpr size_t WS_NEED = 256 * MiB;

constexpr int RING_BYTES = 131072;
constexpr int LDS_BYTES = 135168;

__device__ __forceinline__ unsigned cvt_pk_bf16(float lo, float hi) { f32x2 v = {lo, hi}; bf16x2_t b = __builtin_convertvector(v, bf16x2_t); return __builtin_bit_cast(unsigned, b); }
__device__ __forceinline__ void st_wt16(void* p, u32x4 v) { asm volatile("global_store_dwordx4 %0, %1, off sc0 sc1\n\ts_nop 1" :: "v"(p), "v"(v) : "memory"); }
__device__ __forceinline__ float bf_lo(unsigned u) { return __uint_as_float(u << 16); }
__device__ __forceinline__ float bf_hi(unsigned u) { return __uint_as_float(u & 0xffff0000u); }
__device__ __forceinline__ float fast_sigmoid(float x) { return __builtin_amdgcn_rcpf(1.0f + __builtin_amdgcn_exp2f(-x * LOG2E)); }
template <int CTRL> __device__ __forceinline__ float dpp_f(float v) {
    return __builtin_bit_cast(float, __builtin_amdgcn_update_dpp(0, __builtin_bit_cast(int, v), CTRL, 0xF, 0xF, false));
}
__device__ __forceinline__ float wave_sum(float v) {
    v += dpp_f<0xB1>(v); v += dpp_f<0x4E>(v); v += dpp_f<0x141>(v); v += dpp_f<0x140>(v);
    v += __shfl_xor(v, 16);
    auto rr = __builtin_amdgcn_permlane32_swap(__float_as_uint(v), __float_as_uint(v), false, false);
    return __uint_as_float(rr[0]) + __uint_as_float(rr[1]);
}

namespace pg8 {
constexpr int BM = 256, BK = 64, HALF = 128, HTB = HALF * BK * 2, STAGE_BYTES = 8 * HTB, NXCD = 8, WGM = 8;
__host__ __device__ __forceinline__ int lds_byte(int r, int c) { const int st = (r >> 4) * 2 + (c >> 5), rr = r & 15, cc = c & 31, ob = rr * 64 + cc * 2; return st * 1024 + (ob ^ (((ob >> 9) & 1) << 5)); }
__host__ __device__ __forceinline__ void stage_rc(int b, int& R, int& C) { const int st = b / 1024, sb = b % 1024, swz = sb ^ (((sb >> 9) & 1) << 5); R = (st >> 1) * 16 + swz / 64; C = (st & 1) * 32 + (swz % 64) / 2; }
__host__ __device__ __forceinline__ int perm32(int rho) { const int n = rho >> 4, i = rho & 15; return 8 * (i >> 2) + 4 * n + (i & 3); }

struct Unit { int pm, pn; };
struct Gemm { const bf16* A; const bf16* Bt; int K; };

struct StaticOrder {
    int nM, nN, nwg, G, c;
    __device__ void init(int nM_, int nN_, int G_, int c_) { nM = nM_; nN = nN_; nwg = nM * nN; G = G_; c = c_; }
    __device__ bool next(int i, Unit& u) const {
        const long L = (long)i * G + c; if (L >= nwg) return false;
        int wgid = (int)L; { const int q = nwg / NXCD, r = nwg % NXCD, xcd = wgid % NXCD, off = wgid / NXCD; wgid = (xcd < r ? xcd * (q + 1) : r * (q + 1) + (xcd - r) * q) + off; }
        const int nig = WGM * nN, gid = wgid / nig, fm = gid * WGM, gsz = (nM - fm) < WGM ? (nM - fm) : WGM;
        u.pm = fm + ((wgid % nig) % gsz); u.pn = (wgid % nig) / gsz; return true;
    }
};

template <class Epi, class Sched>
__device__ __forceinline__ void gemm_phase(LAS unsigned char* lds, const Gemm g, const Sched& S, const Epi& E) {
    const int tid = threadIdx.x, wid = __builtin_amdgcn_readfirstlane(tid >> 6), lane = tid & 63, wr = wid >> 2, wc = wid & 3, fr = lane & 15, fq = lane >> 4;
    const int K = g.K, nt = K / BK;
    constexpr bool HALO = Epi::HALO;
    unsigned voffA[2], voffB[2];
#pragma unroll
    for (int i = 0; i < 2; ++i) { int R, C; stage_rc(tid * 16 + i * 8192, R, C); const int Rb = Epi::PERM ? ((R & ~31) + perm32(R & 31)) : R;
        const int Ra = HALO ? (R - 2 * (R >> 6)) : R;
        voffA[i] = (unsigned)(Ra * K + C) * 2u; voffB[i] = (unsigned)(Rb * K + C) * 2u; }
    const size_t kstep = (size_t)(BK * 2);
    const size_t hstepB = (size_t)HALF * K * 2, tstepB = 2 * hstepB;
    const size_t hstepA = (size_t)(HALO ? 124 : 128) * K * 2, tstepA = 2 * hstepA;
    const char* Abase = (const char*)g.A - (HALO ? (size_t)2 * K * 2 : (size_t)0);
    const unsigned ldsw = (unsigned)wid * 1024u;
    const int aoff = lds_byte(wr * 64 + fr, fq * 8), boff = lds_byte(wc * 32 + fr, fq * 8);
#define PG8_SA(b, h) (((b) * 2 + (h)) * HTB)
#define PG8_SB(b, h) ((4 + (b) * 2 + (h)) * HTB)
#define PG8_STAGE(bufoff, gbase, voff) do { _Pragma("unroll") for (int _i = 0; _i < 2; ++_i) \
        __builtin_amdgcn_global_load_lds((const unsigned*)((const char*)(gbase) + (voff)[_i]), (LAS unsigned*)(lds + (bufoff) + ldsw + _i * 8192), 16, 0, 0); } while (0)
#define PG8_LDA(dst, b, h) do { _Pragma("unroll") for (int m = 0; m < 4; ++m) _Pragma("unroll") for (int k = 0; k < 2; ++k) dst[m][k] = *(const LAS bf16x8*)(lds + PG8_SA(b, h) + aoff + m * 2048 + k * 1024); } while (0)
#define PG8_LDB(dst, b, h) do { _Pragma("unroll") for (int n = 0; n < 2; ++n) _Pragma("unroll") for (int k = 0; k < 2; ++k) dst[n][k] = *(const LAS bf16x8*)(lds + PG8_SB(b, h) + boff + n * 2048 + k * 1024); } while (0)
#define PG8_MMA(ai, bj, At, Bt) do { __builtin_amdgcn_s_setprio(1); _Pragma("unroll") for (int m = 0; m < 4; ++m) _Pragma("unroll") for (int n = 0; n < 2; ++n) _Pragma("unroll") for (int k = 0; k < 2; ++k) \
        acc[ai][bj][m][n] = __builtin_amdgcn_mfma_f32_16x16x32_bf16(Bt[n][k], At[m][k], acc[ai][bj][m][n], 0, 0, 0); __builtin_amdgcn_s_setprio(0); } while (0)
#define PG8_WAIT_V(n) asm volatile("s_waitcnt vmcnt(" #n ")" ::: "memory")
#define PG8_WAIT_L(n) asm volatile("s_waitcnt lgkmcnt(" #n ")" ::: "memory")
#define PG8_BAR __builtin_amdgcn_s_barrier()
#define PG8_SCHED __builtin_amdgcn_sched_barrier(0)
    Unit cur, nxt; int ui = 0;
    if (!S.next(0, cur)) return;
    f32x4 acc[2][2][4][2];
#pragma unroll
    for (int a = 0; a < 2; ++a)
#pragma unroll
        for (int b = 0; b < 2; ++b)
#pragma unroll
            for (int m = 0; m < 4; ++m)
#pragma unroll
                for (int n = 0; n < 2; ++n) acc[a][b][m][n] = (f32x4){0.f, 0.f, 0.f, 0.f};
    bf16x8 At[4][2], B0[2][2], B1[2][2];
    const char* cA = Abase + (size_t)cur.pm * tstepA; const char* cB = (const char*)g.Bt + (size_t)cur.pn * tstepB;
    PG8_STAGE(PG8_SB(0, 0), cB, voffB); PG8_STAGE(PG8_SB(0, 1), cB + hstepB, voffB); PG8_STAGE(PG8_SA(0, 0), cA, voffA); PG8_STAGE(PG8_SA(0, 1), cA + hstepA, voffA);
    if (wr == 1) PG8_BAR;
    PG8_WAIT_V(2); PG8_BAR;
    PG8_STAGE(PG8_SB(1, 0), cB + kstep, voffB); PG8_STAGE(PG8_SA(1, 0), cA + kstep, voffA); PG8_STAGE(PG8_SB(1, 1), cB + hstepB + kstep, voffB);
    PG8_WAIT_V(6); PG8_BAR;
    for (;;) {
        const bool has_next = S.next(ui + 1, nxt);
        const char* nA = has_next ? Abase + (size_t)nxt.pm * tstepA : cA; const char* nB = has_next ? (const char*)g.Bt + (size_t)nxt.pn * tstepB : cB;
        for (int t = 0; t < nt; t += 2) {
            if constexpr (Epi::HAS_MID) { if (t == (nt >> 1)) E.mid(acc, cur, wr, wc, fr, fq); }
            const bool last = (t == nt - 2);
            const char* a1 = cA + (size_t)(t + 1) * kstep;
            const char* a2 = last ? nA : cA + (size_t)(t + 2) * kstep; const char* b2 = last ? nB : cB + (size_t)(t + 2) * kstep;
            const char* a3 = a2 + kstep; const char* b3 = b2 + kstep;
            PG8_LDB(B0, 0, 0); PG8_LDB(B1, 0, 1); PG8_SCHED; PG8_LDA(At, 0, 0); PG8_STAGE(PG8_SA(1, 1), a1 + hstepA, voffA);
            PG8_WAIT_V(8); PG8_WAIT_L(0); PG8_BAR; PG8_MMA(0, 0, At, B0); PG8_MMA(0, 1, At, B1); PG8_BAR; PG8_SCHED;
            PG8_LDA(At, 0, 1); PG8_STAGE(PG8_SB(0, 0), b2, voffB); PG8_STAGE(PG8_SB(0, 1), b2 + hstepB, voffB); PG8_STAGE(PG8_SA(0, 0), a2, voffA);
            PG8_WAIT_V(8); PG8_WAIT_L(0); PG8_BAR; PG8_MMA(1, 0, At, B0); PG8_MMA(1, 1, At, B1); PG8_BAR; PG8_SCHED;
            PG8_LDB(B0, 1, 0); PG8_LDB(B1, 1, 1); PG8_SCHED; PG8_LDA(At, 1, 0); PG8_STAGE(PG8_SA(0, 1), a2 + hstepA, voffA);
            PG8_WAIT_V(8); PG8_WAIT_L(0); PG8_BAR; PG8_MMA(0, 0, At, B0); PG8_MMA(0, 1, At, B1); PG8_BAR; PG8_SCHED;
            PG8_LDA(At, 1, 1); PG8_STAGE(PG8_SB(1, 0), b3, voffB); PG8_STAGE(PG8_SB(1, 1), b3 + hstepB, voffB); PG8_STAGE(PG8_SA(1, 0), a3, voffA);
            PG8_WAIT_V(8); PG8_WAIT_L(0); PG8_BAR; PG8_MMA(1, 0, At, B0); PG8_MMA(1, 1, At, B1); PG8_BAR; PG8_SCHED;
        }
        if (wr == 0) PG8_BAR;
        if constexpr (!Epi::AFTER_DRAIN) E(acc, cur, wr, wc, fr, fq);
        if (!has_next) break;
#pragma unroll
        for (int a = 0; a < 2; ++a)
#pragma unroll
            for (int b = 0; b < 2; ++b)
#pragma unroll
                for (int m = 0; m < 4; ++m)
#pragma unroll
                    for (int n = 0; n < 2; ++n) acc[a][b][m][n] = (f32x4){0.f, 0.f, 0.f, 0.f};
        cur = nxt; cA = nA; cB = nB; ++ui;
        if (wr == 1) PG8_BAR;
    }
    PG8_WAIT_V(0);
    PG8_BAR;
    if constexpr (Epi::AFTER_DRAIN) E.fused(acc, cur, wr, wc, fr, fq, lds, wid, lane);
#undef PG8_SA
#undef PG8_SB
#undef PG8_STAGE
#undef PG8_LDA
#undef PG8_LDB
#undef PG8_MMA
#undef PG8_WAIT_V
#undef PG8_WAIT_L
#undef PG8_BAR
#undef PG8_SCHED
}

struct EpiZ {
    static constexpr bool PERM = true, HALO = false, HAS_MID = false, AFTER_DRAIN = false;
    bf16* qkv; bf16* sga; bf16* sgb; const float* cosT; const float* sinT; unsigned* kh;
    __device__ __forceinline__ void mid(f32x4 (&)[2][2][4][2], const Unit&, int, int, int, int) const {}
    __device__ __forceinline__ void operator()(f32x4 (&acc)[2][2][4][2], const Unit& u, int wr, int wc, int fr, int fq) const {
        if ((u.pn >> 1) == 1) {
#pragma unroll
            for (int bj = 0; bj < 2; ++bj) {
                float mx = 0.f;
#pragma unroll
                for (int ai = 0; ai < 2; ++ai)
#pragma unroll
                    for (int m = 0; m < 4; ++m) { const f32x4 a = acc[ai][bj][m][0], b = acc[ai][bj][m][1];
                        float q = ((a[0] * a[0] + a[1] * a[1]) + (a[2] * a[2] + a[3] * a[3])) + ((b[0] * b[0] + b[1] * b[1]) + (b[2] * b[2] + b[3] * b[3]));
                        q += __shfl_xor(q, 16); q += __shfl_xor(q, 32); mx = fmaxf(mx, q); }
                mx = fmaxf(mx, __shfl_xor(mx, 1)); mx = fmaxf(mx, __shfl_xor(mx, 2)); mx = fmaxf(mx, __shfl_xor(mx, 4)); mx = fmaxf(mx, __shfl_xor(mx, 8));
                if (fr == 0 && fq == 0) { const int head = ((u.pn & 1) * 256 + bj * 128 + wc * 32) >> 6, bb = (u.pm * 256) / SEQ;
                    atomicMax(kh + (bb * NH + head) * 2 + (wc & 1), __float_as_uint(mx)); }
            }
        }
        const int pn = u.pn; bf16* base; int ldc, colt, mode;
        if (pn < 12) { const int reg = pn >> 1; base = qkv + (size_t)reg * T * 512; ldc = 512; colt = (pn & 1) * 256; mode = (reg == 0) ? 1 : (reg == 3) ? 3 : (reg == 4) ? 2 : 0; }
        else if (pn < 16) { base = sga; ldc = 1024; colt = (pn - 12) * 256; mode = 4; }
        else { base = sgb; ldc = 1024; colt = (pn - 16) * 256; mode = 4; }
        const int row0 = u.pm * 256 + wr * 64 + fr, col0 = colt + wc * 32 + 8 * fq;
        const bool rope = (mode & 2) && ((wc & 1) == 0);
        const float sc = (mode & 1) ? QSCALE : 1.0f;
        const float sgn = (fq == 0) ? -1.0f : 1.0f;
        if (rope) {
#pragma unroll
            for (int ai = 0; ai < 2; ++ai)
#pragma unroll
                for (int m = 0; m < 4; ++m) {
                    const int pos = (row0 + ai * 128 + m * 16) & (SEQ - 1);
                    const f32x4 cs0 = *(const f32x4*)(cosT + pos * 8), cs1 = *(const f32x4*)(cosT + pos * 8 + 4), sn0 = *(const f32x4*)(sinT + pos * 8), sn1 = *(const f32x4*)(sinT + pos * 8 + 4);
#pragma unroll
                    for (int bj = 0; bj < 2; ++bj) {
                        f32x4 v0 = acc[ai][bj][m][0], v1 = acc[ai][bj][m][1], p0, p1;
#pragma unroll
                        for (int j = 0; j < 4; ++j) { p0[j] = __shfl_xor(v0[j], 16); p1[j] = __shfl_xor(v1[j], 16); }
                        if (fq < 2) {
#pragma unroll
                            for (int j = 0; j < 4; ++j) { v0[j] = v0[j] * cs0[j] + sgn * p0[j] * sn0[j]; v1[j] = v1[j] * cs1[j] + sgn * p1[j] * sn1[j]; }
                        }
                        acc[ai][bj][m][0] = v0; acc[ai][bj][m][1] = v1;
                    }
                }
        }
#pragma unroll
        for (int ai = 0; ai < 2; ++ai)
#pragma unroll
            for (int m = 0; m < 4; ++m) {
                const int row = row0 + ai * 128 + m * 16;
                bf16* rowp = base + (size_t)row * ldc + col0;
#pragma unroll
                for (int bj = 0; bj < 2; ++bj) {
                    f32x4 v0 = acc[ai][bj][m][0], v1 = acc[ai][bj][m][1];
                    if (mode == 4) {
#pragma unroll
                        for (int j = 0; j < 4; ++j) { v0[j] = fast_sigmoid(v0[j]); v1[j] = fast_sigmoid(v1[j]); }
                    } else {
                        v0 = v0 * sc; v1 = v1 * sc;
                    }
                    u32x4 w; w.x = cvt_pk_bf16(v0[0], v0[1]); w.y = cvt_pk_bf16(v0[2], v0[3]); w.z = cvt_pk_bf16(v1[0], v1[1]); w.w = cvt_pk_bf16(v1[2], v1[3]);
                    if (pn >= 12) __builtin_nontemporal_store(w, (u32x4*)(rowp + bj * 128)); else *(u32x4*)(rowp + bj * 128) = w;
                }
            }
    }
};

struct EpiMix {
    static constexpr bool PERM = true, HALO = false, HAS_MID = true, AFTER_DRAIN = false;
    const bf16* sga; const bf16* sgb; bf16* out;
    __device__ __forceinline__ void mid(f32x4 (&acc)[2][2][4][2], const Unit& u, int wr, int wc, int fr, int fq) const {
        unsigned opq; asm volatile("v_mov_b32 %0, 0" : "=v"(opq));
        const unsigned base = (unsigned)((u.pm * 256 + wr * 64 + fr) * D + u.pn * 256 + wc * 32 + 8 * fq) * 2u + opq;
#pragma unroll
        for (int ai = 0; ai < 2; ++ai)
#pragma unroll
            for (int m = 0; m < 4; ++m) {
                const unsigned off = base + (unsigned)((ai * 128 + m * 16) * D) * 2u;
#pragma unroll
                for (int bj = 0; bj < 2; ++bj) {
                    const u32x4 a = __builtin_nontemporal_load((const u32x4*)((const char*)sga + (off + bj * 256))), b = *(const u32x4*)((const char*)sgb + (off + bj * 256));
                    f32x4 r0, r1;
                    r0[0] = bf_lo(a.x) * __builtin_amdgcn_rcpf(bf_lo(b.x)); r0[1] = bf_hi(a.x) * __builtin_amdgcn_rcpf(bf_hi(b.x));
                    r0[2] = bf_lo(a.y) * __builtin_amdgcn_rcpf(bf_lo(b.y)); r0[3] = bf_hi(a.y) * __builtin_amdgcn_rcpf(bf_hi(b.y));
                    r1[0] = bf_lo(a.z) * __builtin_amdgcn_rcpf(bf_lo(b.z)); r1[1] = bf_hi(a.z) * __builtin_amdgcn_rcpf(bf_hi(b.z));
                    r1[2] = bf_lo(a.w) * __builtin_amdgcn_rcpf(bf_lo(b.w)); r1[3] = bf_hi(a.w) * __builtin_amdgcn_rcpf(bf_hi(b.w));
                    acc[ai][bj][m][0] = acc[ai][bj][m][0] * r0; acc[ai][bj][m][1] = acc[ai][bj][m][1] * r1;
                }
                if (m == 3) asm volatile("" ::: "memory");
            }
    }
    __device__ __forceinline__ void operator()(f32x4 (&acc)[2][2][4][2], const Unit& u, int wr, int wc, int fr, int fq) const {
        const int row0 = u.pm * 256 + wr * 64 + fr, col0 = u.pn * 256 + wc * 32 + 8 * fq;
#pragma unroll
        for (int ai = 0; ai < 2; ++ai)
#pragma unroll
            for (int m = 0; m < 4; ++m) {
                const size_t off = (size_t)(row0 + ai * 128 + m * 16) * D + col0;
#pragma unroll
                for (int bj = 0; bj < 2; ++bj) {
                    const u32x4 b = __builtin_nontemporal_load((const u32x4*)(sgb + off + bj * 128));
                    const f32x4 v0 = acc[ai][bj][m][0], v1 = acc[ai][bj][m][1];
                    u32x4 w;
                    w.x = cvt_pk_bf16(v0[0] * bf_lo(b.x), v0[1] * bf_hi(b.x)); w.y = cvt_pk_bf16(v0[2] * bf_lo(b.y), v0[3] * bf_hi(b.y));
                    w.z = cvt_pk_bf16(v1[0] * bf_lo(b.z), v1[1] * bf_hi(b.z)); w.w = cvt_pk_bf16(v1[2] * bf_lo(b.w), v1[3] * bf_hi(b.w));
                    *(u32x4*)(out + off + bj * 128) = w;
                }
                if (m == 3) asm volatile("" ::: "memory");
            }
    }
};

struct EpiF32 {
    static constexpr bool PERM = false, HALO = false, HAS_MID = false, AFTER_DRAIN = false;
    float* out;
    __device__ __forceinline__ void mid(f32x4 (&)[2][2][4][2], const Unit&, int, int, int, int) const {}
    __device__ __forceinline__ void operator()(f32x4 (&acc)[2][2][4][2], const Unit& u, int wr, int wc, int fr, int fq) const {
        const int row0 = u.pm * 256 + wr * 64 + fr, col0 = u.pn * 256 + wc * 32 + 4 * fq;
#pragma unroll
        for (int ai = 0; ai < 2; ++ai)
#pragma unroll
            for (int m = 0; m < 4; ++m) {
                float* rowp = out + (size_t)(row0 + ai * 128 + m * 16) * D + col0;
#pragma unroll
                for (int bj = 0; bj < 2; ++bj)
#pragma unroll
                    for (int n = 0; n < 2; ++n) *(f32x4*)(rowp + bj * 128 + n * 16) = acc[ai][bj][m][n];
            }
    }
};

template <int CTRL> __device__ __forceinline__ float dpp0_f(float v) {
    return __builtin_bit_cast(float, __builtin_amdgcn_update_dpp(0, __builtin_bit_cast(int, v), CTRL, 0xF, 0xF, true));
}
struct EpiConvGelu {
    static constexpr bool PERM = true, HALO = true, HAS_MID = false, AFTER_DRAIN = false;
    const float* cw; const float* cb; bf16* out;
    __device__ __forceinline__ void mid(f32x4 (&)[2][2][4][2], const Unit&, int, int, int, int) const {}
    __device__ __forceinline__ void operator()(f32x4 (&acc)[2][2][4][2], const Unit& u, int wr, int wc, int fr, int fq) const {
        const int ca0 = u.pn * 128 + wc * 32 + 8 * fq;
        const float f0 = (fr == 0) ? 1.0f : 0.0f, f1 = (fr < 2) ? 1.0f : 0.0f;
        constexpr float GC1 = -1.5957691216057308f * LOG2E, GC2 = GC1 * 0.044715f;
#pragma unroll
        for (int n = 0; n < 2; ++n) {
            const int ca = ca0 + 4 * n;
            const f32x4 wa0 = *(const f32x4*)(cw + ca), wa1 = *(const f32x4*)(cw + NUP + ca), wa2 = *(const f32x4*)(cw + 2 * NUP + ca), ba = *(const f32x4*)(cb + ca);
            const f32x4 wb0 = *(const f32x4*)(cw + FF + ca), wb1 = *(const f32x4*)(cw + NUP + FF + ca), wb2 = *(const f32x4*)(cw + 2 * NUP + FF + ca), bb = *(const f32x4*)(cb + FF + ca);
#pragma unroll
            for (int ai = 0; ai < 2; ++ai) {
                const int s = 2 * ai + wr;
#pragma unroll
                for (int m = 0; m < 4; ++m) {
                    const int li = 16 * m + fr; const int grow = u.pm * 248 + 62 * s + li - 2;
                    const int tpos = grow & (SEQ - 1);
                    const int mp = (m > 0) ? m - 1 : 0;
                    float p1a[4], p2a[4], p1b[4], p2b[4];
#pragma unroll
                    for (int j = 0; j < 4; ++j) {
                        const float xa = acc[ai][0][m][n][j], xb = acc[ai][1][m][n][j], xap = acc[ai][0][mp][n][j], xbp = acc[ai][1][mp][n][j];
                        p1a[j] = dpp_f<0x121>(xap) * f0 + dpp0_f<0x111>(xa); p2a[j] = dpp_f<0x122>(xap) * f1 + dpp0_f<0x112>(xa);
                        p1b[j] = dpp_f<0x121>(xbp) * f0 + dpp0_f<0x111>(xb); p2b[j] = dpp_f<0x122>(xbp) * f1 + dpp0_f<0x112>(xb);
                    }
                    if (__any((int)(tpos < 2))) {
                        const float k1 = (tpos >= 1) ? 1.0f : 0.0f, k2 = (tpos >= 2) ? 1.0f : 0.0f;
#pragma unroll
                        for (int j = 0; j < 4; ++j) { p1a[j] *= k1; p2a[j] *= k2; p1b[j] *= k1; p2b[j] *= k2; }
                    }
                    float o[4];
#pragma unroll
                    for (int j = 0; j < 4; ++j) {
                        const float xa = acc[ai][0][m][n][j], xb = acc[ai][1][m][n][j];
                        const float va = wa0[j] * p2a[j] + (wa1[j] * p1a[j] + (wa2[j] * xa + ba[j]));
                        const float vb = wb0[j] * p2b[j] + (wb1[j] * p1b[j] + (wb2[j] * xb + bb[j]));
                        const float e = __builtin_amdgcn_exp2f(va * (GC1 + GC2 * (va * va)));
                        o[j] = va * vb * __builtin_amdgcn_rcpf(1.0f + e);
                    }
                    if (li >= 2 && grow < T) { u32x2 w; w.x = cvt_pk_bf16(o[0], o[1]); w.y = cvt_pk_bf16(o[2], o[3]); *(u32x2*)(out + (size_t)grow * FF + ca) = w; }
                }
            }
        }
    }
};

struct PanelSS {
    unsigned* xbuf;
    unsigned* cnt;
    __device__ __forceinline__ void run(const f32x4 (&v)[2][2][4][2], const Unit& u, int wr, int wc, int fr, int fq, LAS unsigned char* lds, int wid, int lane) const {
        LAS float* P = (LAS float*)lds;
        LAS float* S = (LAS float*)(lds + 4096);
#pragma unroll
        for (int ai = 0; ai < 2; ++ai)
#pragma unroll
            for (int m = 0; m < 4; ++m) {
                float q = 0.f;
#pragma unroll
                for (int bj = 0; bj < 2; ++bj)
#pragma unroll
                    for (int n = 0; n < 2; ++n) { const f32x4 x = v[ai][bj][m][n]; q += (x[0] * x[0] + x[1] * x[1]) + (x[2] * x[2] + x[3] * x[3]); }
                q += __shfl_xor(q, 16); q += __shfl_xor(q, 32);
                if (fq == 0) P[(ai * 128 + wr * 64 + m * 16 + fr) * 4 + wc] = q;
            }
        asm volatile("s_waitcnt lgkmcnt(0)" ::: "memory"); __builtin_amdgcn_s_barrier(); asm volatile("" ::: "memory");
        const int row = wid * 32 + (lane & 31);
        if (lane < 32) {
            const float t = (P[row * 4 + 0] + P[row * 4 + 1]) + (P[row * 4 + 2] + P[row * 4 + 3]);
            __hip_atomic_store(xbuf + ((size_t)(u.pm * 256 + row) * 4 + u.pn), __float_as_uint(t), __ATOMIC_RELAXED, __HIP_MEMORY_SCOPE_AGENT);
        }
        asm volatile("s_waitcnt vmcnt(0)" ::: "memory");
        if (lane == 0) __hip_atomic_fetch_add(cnt + 64 * u.pm, 1u, __ATOMIC_RELAXED, __HIP_MEMORY_SCOPE_AGENT);
        if (wid == 0) {
            unsigned sp = 0;
            for (;;) {
                if ((unsigned)__builtin_amdgcn_readfirstlane(__hip_atomic_load(cnt + 64 * u.pm, __ATOMIC_RELAXED, __HIP_MEMORY_SCOPE_AGENT)) >= 32u) break;
                if (++sp > (1u << 22)) break;
                __builtin_amdgcn_s_sleep(2);
            }
            __builtin_amdgcn_fence(__ATOMIC_ACQUIRE, "agent");
        }
        asm volatile("s_waitcnt vmcnt(0) lgkmcnt(0)" ::: "memory"); __builtin_amdgcn_s_barrier(); asm volatile("" ::: "memory");
        if (lane < 32) {
            const unsigned* slot = xbuf + (size_t)(u.pm * 256 + row) * 4; float t = 0.f;
#pragma unroll
            for (int k = 0; k < 4; ++k) t += __uint_as_float(__hip_atomic_load(slot + k, __ATOMIC_RELAXED, __HIP_MEMORY_SCOPE_AGENT));
            S[row] = 1.0f / sqrtf(t * (1.0f / 1024.0f) + RMS_EPS);
        }
        asm volatile("s_waitcnt lgkmcnt(0)" ::: "memory"); __builtin_amdgcn_s_barrier(); asm volatile("" ::: "memory");
    }
};
struct EpiNormA {
    static constexpr bool PERM = false, HALO = false, HAS_MID = false, AFTER_DRAIN = true;
    const float* x; float* out; bf16* h2; const float* g1; const float* g2; PanelSS st1, st2;
    __device__ __forceinline__ void mid(f32x4 (&)[2][2][4][2], const Unit&, int, int, int, int) const {}
    __device__ __forceinline__ void fused(f32x4 (&acc)[2][2][4][2], const Unit& u, int wr, int wc, int fr, int fq, LAS unsigned char* lds, int wid, int lane) const {
        const LAS float* S = (const LAS float*)(lds + 4096);
        const int col0 = u.pn * 256 + wc * 32 + 4 * fq;
        f32x4 pre[4][2][2];
#pragma unroll
        for (int m = 0; m < 4; ++m) { const size_t off = (size_t)(u.pm * 256 + wr * 64 + m * 16 + fr) * D + col0;
#pragma unroll
            for (int bj = 0; bj < 2; ++bj)
#pragma unroll
                for (int n = 0; n < 2; ++n) pre[m][bj][n] = __builtin_nontemporal_load((const f32x4*)(x + off + bj * 128 + n * 16)); }
        st1.run(acc, u, wr, wc, fr, fq, lds, wid, lane);
        f32x4 gv[2][2];
#pragma unroll
        for (int bj = 0; bj < 2; ++bj)
#pragma unroll
            for (int n = 0; n < 2; ++n) gv[bj][n] = *(const f32x4*)(g1 + col0 + bj * 128 + n * 16);
#pragma unroll
        for (int ai = 0; ai < 2; ++ai)
#pragma unroll
            for (int m = 0; m < 4; ++m) { const int r = ai * 128 + wr * 64 + m * 16 + fr; const float inv = S[r]; const size_t off = (size_t)(u.pm * 256 + r) * D + col0;
#pragma unroll
                for (int bj = 0; bj < 2; ++bj)
#pragma unroll
                    for (int n = 0; n < 2; ++n) { const f32x4 xv = (ai == 0) ? pre[m][bj][n] : __builtin_nontemporal_load((const f32x4*)(x + off + bj * 128 + n * 16)); acc[ai][bj][m][n] = xv + acc[ai][bj][m][n] * inv * gv[bj][n]; }
                asm volatile("" : "+v"(acc[ai][0][m][0]), "+v"(acc[ai][0][m][1]), "+v"(acc[ai][1][m][0]), "+v"(acc[ai][1][m][1]));
                if (m & 1) asm volatile("" ::: "memory"); }
        st2.run(acc, u, wr, wc, fr, fq, lds, wid, lane);
#pragma unroll
        for (int bj = 0; bj < 2; ++bj)
#pragma unroll
            for (int n = 0; n < 2; ++n) gv[bj][n] = *(const f32x4*)(g2 + col0 + bj * 128 + n * 16);
#pragma unroll
        for (int ai = 0; ai < 2; ++ai)
#pragma unroll
            for (int m = 0; m < 4; ++m) { const int r = ai * 128 + wr * 64 + m * 16 + fr; const float inv = S[r]; const size_t off = (size_t)(u.pm * 256 + r) * D + col0;
#pragma unroll
                for (int bj = 0; bj < 2; ++bj)
#pragma unroll
                    for (int n = 0; n < 2; ++n) { const f32x4 x1 = acc[ai][bj][m][n]; __builtin_nontemporal_store(x1, (f32x4*)(out + off + bj * 128 + n * 16));
                        const f32x4 o = x1 * inv * gv[bj][n]; u32x2 w; w.x = cvt_pk_bf16(o[0], o[1]); w.y = cvt_pk_bf16(o[2], o[3]); *(u32x2*)(h2 + off + bj * 128 + n * 16) = w; }
                asm volatile("" ::: "memory"); }
    }
};
struct EpiNormB {
    static constexpr bool PERM = false, HALO = false, HAS_MID = false, AFTER_DRAIN = true;
    const float* base; float* out; const float* g; PanelSS st;
    __device__ __forceinline__ void mid(f32x4 (&)[2][2][4][2], const Unit&, int, int, int, int) const {}
    __device__ __forceinline__ void fused(f32x4 (&acc)[2][2][4][2], const Unit& u, int wr, int wc, int fr, int fq, LAS unsigned char* lds, int wid, int lane) const {
        const LAS float* S = (const LAS float*)(lds + 4096);
        const int col0 = u.pn * 256 + wc * 32 + 4 * fq;
        f32x4 pre[4][2][2];
#pragma unroll
        for (int m = 0; m < 4; ++m) { const size_t off = (size_t)(u.pm * 256 + wr * 64 + m * 16 + fr) * D + col0;
#pragma unroll
            for (int bj = 0; bj < 2; ++bj)
#pragma unroll
                for (int n = 0; n < 2; ++n) pre[m][bj][n] = __builtin_nontemporal_load((const f32x4*)(base + off + bj * 128 + n * 16)); }
        st.run(acc, u, wr, wc, fr, fq, lds, wid, lane);
        f32x4 gv[2][2];
#pragma unroll
        for (int bj = 0; bj < 2; ++bj)
#pragma unroll
            for (int n = 0; n < 2; ++n) gv[bj][n] = *(const f32x4*)(g + col0 + bj * 128 + n * 16);
#pragma unroll
        for (int ai = 0; ai < 2; ++ai)
#pragma unroll
            for (int m = 0; m < 4; ++m) { const int r = ai * 128 + wr * 64 + m * 16 + fr; const float inv = S[r]; const size_t off = (size_t)(u.pm * 256 + r) * D + col0;
#pragma unroll
                for (int bj = 0; bj < 2; ++bj)
#pragma unroll
                    for (int n = 0; n < 2; ++n) { const f32x4 bs = (ai == 0) ? pre[m][bj][n] : __builtin_nontemporal_load((const f32x4*)(base + off + bj * 128 + n * 16)); __builtin_nontemporal_store(bs + acc[ai][bj][m][n] * inv * gv[bj][n], (f32x4*)(out + off + bj * 128 + n * 16)); }
                if (m & 1) asm volatile("" ::: "memory"); }
    }
};
}

constexpr int A_BUF = 23552, A_KX = 9216, A_V = 11264, A_VP = 192;
constexpr float A_THR = 8.0f;
__device__ __forceinline__ int crow(int r, int hi) { return (r & 3) + 8 * (r >> 2) + 4 * hi; }
#define MFMA32(a, b, c) __builtin_amdgcn_mfma_f32_32x32x16_bf16((a), (b), (c), 0, 0, 0)
typedef short v4i16_t __attribute__((ext_vector_type(4)));
__device__ __forceinline__ v4i16_t vtr(LAS const unsigned char* p) { return __builtin_amdgcn_ds_read_tr16_b64_v4i16((LAS v4i16_t*)p); }
__device__ __forceinline__ float swap_max(float v) { auto rr = __builtin_amdgcn_permlane32_swap(__float_as_uint(v), __float_as_uint(v), false, false); return fmaxf(__uint_as_float(rr[0]), __uint_as_float(rr[1])); }
__device__ __forceinline__ float swap_sum(float v) { auto rr = __builtin_amdgcn_permlane32_swap(__float_as_uint(v), __float_as_uint(v), false, false); return __uint_as_float(rr[0]) + __uint_as_float(rr[1]); }

struct AttnAcc { f32x16 o0, o1, negm; float m, l; bool first; };
__device__ __forceinline__ void attn_init(AttnAcc& st) {
#pragma unroll
    for (int r = 0; r < 16; ++r) { st.o0[r] = 0.f; st.o1[r] = 0.f; st.negm[r] = 0.f; }
    st.m = 0.f; st.l = 0.f; st.first = true;
}

template <int MODE, bool BIAS>
__device__ __forceinline__ void attn_tile(AttnAcc& st, const bf16x8 (&qr)[4], const bf16x8 qx, LAS const unsigned char* Ks, LAS const unsigned char* Vs,
                                          int r32, int hi, int lane, int qidx, int k0, bool domask) {
    f32x16 p0, p1;
    LAS const unsigned char* kp = Ks + r32 * 144 + hi * 16;
    {
        const bf16x8 k0f = *(LAS const bf16x8*)(kp), k1f = *(LAS const bf16x8*)(kp + 32 * 144);
        p0 = MFMA32(k0f, qr[0], st.negm); p1 = MFMA32(k1f, qr[0], st.negm);
    }
#pragma unroll
    for (int d0 = 1; d0 < 4; ++d0) {
        const bf16x8 k0f = *(LAS const bf16x8*)(kp + d0 * 32), k1f = *(LAS const bf16x8*)(kp + 32 * 144 + d0 * 32);
        p0 = MFMA32(k0f, qr[d0], p0); p1 = MFMA32(k1f, qr[d0], p1);
    }
    if (BIAS) {
        LAS const unsigned char* xp = Ks + A_KX + r32 * 32 + hi * 16;
        const bf16x8 x0 = *(LAS const bf16x8*)(xp), x1 = *(LAS const bf16x8*)(xp + 32 * 32);
        p0 = MFMA32(x0, qx, p0); p1 = MFMA32(x1, qx, p1);
    }
    LAS const unsigned char* vp = Vs + (4 * hi + ((lane & 15) >> 2)) * A_VP + (16 * ((lane >> 4) & 1) + 4 * (lane & 3)) * 2;
    v4i16_t va0[4], va1[4], vb0[4], vb1[4];
#pragma unroll
    for (int c = 0; c < 4; ++c) { va0[c] = vtr(vp + (16 * c) * A_VP); va1[c] = vtr(vp + (16 * c + 8) * A_VP); vb0[c] = vtr(vp + (16 * c) * A_VP + 64); vb1[c] = vtr(vp + (16 * c + 8) * A_VP + 64); }
    if (MODE == 1) {
        if (domask)
#pragma unroll
        for (int r = 0; r < 16; ++r) { const int kv = k0 + crow(r, hi); if (kv > qidx) p0[r] = NEGBIG; if (kv + 32 > qidx) p1[r] = NEGBIG; }
    } else if (MODE == 2) {
#pragma unroll
        for (int r = 0; r < 16; ++r) { const int dist = qidx - (k0 + crow(r, hi)); if ((unsigned)dist > 128u) p0[r] = NEGBIG; if ((unsigned)(dist - 32) > 128u) p1[r] = NEGBIG; }
    }
    float rm = fmaxf(fmaxf(p0[0], p1[0]), fmaxf(p0[1], p1[1]));
#pragma unroll
    for (int r = 2; r < 16; r += 2) rm = fmaxf(fmaxf(rm, p0[r]), fmaxf(fmaxf(p1[r], p0[r + 1]), p1[r + 1]));
    rm = swap_max(rm);
    if (__any((int)(st.first || rm > A_THR))) {
        const float dl = st.first ? fmaxf(rm, -64.0f) : fmaxf(rm, 0.0f);
        st.m += dl;
#pragma unroll
        for (int r = 0; r < 16; ++r) { p0[r] -= dl; p1[r] -= dl; }
        const float nm = -st.m;
#pragma unroll
        for (int r = 0; r < 16; ++r) st.negm[r] = nm;
        const float f = __builtin_amdgcn_exp2f(-dl);
        st.l *= f;
#pragma unroll
        for (int r = 0; r < 16; ++r) { st.o0[r] *= f; st.o1[r] *= f; }
        st.first = false;
    }
    float ls = 0.f;
#pragma unroll
    for (int r = 0; r < 16; ++r) { p0[r] = __builtin_amdgcn_exp2f(p0[r]); p1[r] = __builtin_amdgcn_exp2f(p1[r]); ls += p0[r] + p1[r]; }
    st.l += ls;
#pragma unroll
    for (int c = 0; c < 4; ++c) {
        u32x4 pw;
        if (c == 0) { pw.x = cvt_pk_bf16(p0[0], p0[1]); pw.y = cvt_pk_bf16(p0[2], p0[3]); pw.z = cvt_pk_bf16(p0[4], p0[5]); pw.w = cvt_pk_bf16(p0[6], p0[7]); }
        else if (c == 1) { pw.x = cvt_pk_bf16(p0[8], p0[9]); pw.y = cvt_pk_bf16(p0[10], p0[11]); pw.z = cvt_pk_bf16(p0[12], p0[13]); pw.w = cvt_pk_bf16(p0[14], p0[15]); }
        else if (c == 2) { pw.x = cvt_pk_bf16(p1[0], p1[1]); pw.y = cvt_pk_bf16(p1[2], p1[3]); pw.z = cvt_pk_bf16(p1[4], p1[5]); pw.w = cvt_pk_bf16(p1[6], p1[7]); }
        else { pw.x = cvt_pk_bf16(p1[8], p1[9]); pw.y = cvt_pk_bf16(p1[10], p1[11]); pw.z = cvt_pk_bf16(p1[12], p1[13]); pw.w = cvt_pk_bf16(p1[14], p1[15]); }
        const bf16x8 pb = __builtin_bit_cast(bf16x8, pw);
        const v4i16_t a0 = va0[c], a1 = va1[c], b0 = vb0[c], b1 = vb1[c];
        const bf16x8 v0f = (bf16x8){a0[0], a0[1], a0[2], a0[3], a1[0], a1[1], a1[2], a1[3]};
        const bf16x8 v1f = (bf16x8){b0[0], b0[1], b0[2], b0[3], b1[0], b1[1], b1[2], b1[3]};
        st.o0 = MFMA32(v0f, pb, st.o0); st.o1 = MFMA32(v1f, pb, st.o1);
    }
}

#define ATT_STORE(buf) do { \
    *(LAS u32x4*)(lds + (buf) * A_BUF + srow * 144 + sch * 16) = kreg; \
    *(LAS u32x4*)(lds + (buf) * A_BUF + A_V + srow * A_VP + sch * 16) = vreg; } while (0)

__device__ __forceinline__ void attn_finish(AttnAcc& st, bf16* orow, int hi, float* lse_out) {
    const float l = swap_sum(st.l);
    const float inv = 1.0f / l;
#pragma unroll
    for (int g4 = 0; g4 < 4; ++g4) {
        u32x2 w0, w1;
        w0.x = cvt_pk_bf16(st.o0[4 * g4] * inv, st.o0[4 * g4 + 1] * inv); w0.y = cvt_pk_bf16(st.o0[4 * g4 + 2] * inv, st.o0[4 * g4 + 3] * inv);
        w1.x = cvt_pk_bf16(st.o1[4 * g4] * inv, st.o1[4 * g4 + 1] * inv); w1.y = cvt_pk_bf16(st.o1[4 * g4 + 2] * inv, st.o1[4 * g4 + 3] * inv);
        *(u32x2*)(orow + 8 * g4 + 4 * hi) = w0; *(u32x2*)(orow + 32 + 8 * g4 + 4 * hi) = w1;
    }
    if (lse_out && hi == 0) *lse_out = st.m + __builtin_amdgcn_logf(l);
}

__device__ __forceinline__ u32x4 bias_terms(float b) {
    const unsigned h = cvt_pk_bf16(b, 0.f) & 0xffffu; const float r1 = b - __uint_as_float(h << 16);
    const unsigned m = cvt_pk_bf16(r1, 0.f) & 0xffffu; const float r2 = r1 - __uint_as_float(m << 16);
    const unsigned l = cvt_pk_bf16(r2, 0.f) & 0xffffu;
    return (u32x4){h | (m << 16), l, 0u, 0u};
}

__device__ __forceinline__ void fox_unit(LAS unsigned char* lds, int b, int h, int qb, const bf16* QA, const bf16* KA, const bf16* VA, const float* Fall, bf16* O2, const unsigned* khp) {
    const int tid = threadIdx.x, lane = tid & 63, r32 = lane & 31, hi = lane >> 5, wid = __builtin_amdgcn_readfirstlane(tid >> 6);
    const int srow = tid >> 3, sch = tid & 7;
    const long rowbase = (long)b * SEQ; const int q0 = qb * 256;
    const float* Fh = Fall + (size_t)(b * NH + h) * SEQ;
    const float fref = Fh[q0];
    const bf16* Kh = KA + rowbase * 512 + h * 64 + 8 * sch; const bf16* Vh = VA + rowbase * 512 + h * 64 + 8 * sch;
    const int qidx = q0 + wid * 32 + r32;
    bf16x8 qr[4];
    { const bf16* qp = QA + (rowbase + qidx) * 512 + h * 64 + hi * 8;
#pragma unroll
      for (int d0 = 0; d0 < 4; ++d0) qr[d0] = __builtin_nontemporal_load((const bf16x8*)(qp + d0 * 16)); }
    const short one = (hi == 0) ? (short)0x3F80 : (short)0;
    const bf16x8 qx = (bf16x8){one, one, one, 0, 0, 0, 0, 0};
    AttnAcc st; attn_init(st);
    const int NT = 4 * (qb + 1);
    int t0 = 0;
    {
        float qq = 0.f;
#pragma unroll
        for (int d0 = 0; d0 < 4; ++d0)
#pragma unroll
            for (int e = 0; e < 8; ++e) { const float f = __uint_as_float(((unsigned)(unsigned short)qr[d0][e]) << 16); qq += f * f; }
        qq = swap_sum(qq);
        qq = fmaxf(qq, __shfl_xor(qq, 1)); qq = fmaxf(qq, __shfl_xor(qq, 2)); qq = fmaxf(qq, __shfl_xor(qq, 4)); qq = fmaxf(qq, __shfl_xor(qq, 8)); qq = fmaxf(qq, __shfl_xor(qq, 16));
        LAS float* ctl = (LAS float*)(lds + 48000);
        if (lane == 0) ctl[wid] = qq;
        __syncthreads();
        float q2 = ctl[0];
#pragma unroll
        for (int w = 1; w < 8; ++w) q2 = fmaxf(q2, ctl[w]);
        const float k2 = __uint_as_float(khp[(b * NH + h) * 2]) + __uint_as_float(khp[(b * NH + h) * 2 + 1]);
        const float thr = 150.0f + 2.04f * sqrtf(q2 * k2);
        const bool skip = (lane < 4 * qb) && ((fref - Fh[64 * lane + 63]) * LOG2E < -thr);
        t0 = __popcll(__ballot(skip));
    }
    u32x4 kreg, vreg; float breg = 0.f;
    { const size_t ro = (size_t)(64 * (NT - 1) + srow) * 512; kreg = *(const u32x4*)(Kh + ro); vreg = *(const u32x4*)(Vh + ro); if (tid < 64) breg = (fref - Fh[64 * (NT - 1) + tid]) * LOG2E; }
    const int qmin = q0 + wid * 32, qmax = qmin + 31;
    for (int t = NT - 1; t >= t0; --t) {
        const int buf = t & 1;
        ATT_STORE(buf);
        if (tid < 64) { LAS u32x4* xp = (LAS u32x4*)(lds + buf * A_BUF + A_KX + tid * 32); xp[0] = bias_terms(breg); xp[1] = (u32x4){0u, 0u, 0u, 0u}; }
        __syncthreads();
        if (t > t0) { const size_t ro = (size_t)(64 * (t - 1) + srow) * 512; kreg = *(const u32x4*)(Kh + ro); vreg = *(const u32x4*)(Vh + ro); if (tid < 64) breg = (fref - Fh[64 * (t - 1) + tid]) * LOG2E; }
        const int k0 = 64 * t;
        if (k0 <= qmax) {
            LAS const unsigned char* Ks = lds + buf * A_BUF; LAS const unsigned char* Vs = lds + buf * A_BUF + A_V;
            attn_tile<1, true>(st, qr, qx, Ks, Vs, r32, hi, lane, qidx, k0, k0 + 63 > qmin);
        }
    }
    attn_finish(st, O2 + (rowbase + qidx) * 1024 + h * 64, hi, nullptr);
    __syncthreads();
}

constexpr int DL_V = 384 * 144;
struct DilU { int g, b, h, r, u, d; };
__device__ __forceinline__ DilU dil_decode(int id) {
    DilU U; U.g = id / 512; const int rest = id % 512, bh = rest >> 4, idx = rest & 15; U.b = bh >> 3; U.h = bh & 7;
    if (U.g == 0) { U.r = 0; U.u = idx; U.d = 1; } else if (U.g == 1) { U.r = idx & 3; U.u = idx >> 2; U.d = 4; } else { U.r = idx; U.u = 0; U.d = 16; }
    return U;
}
__device__ __forceinline__ void dil_phase(LAS unsigned char* lds, int bx, int G, const bf16* QB, const bf16* KB, const bf16* VB, bf16* OD, float* LSE) {
    const int tid = threadIdx.x, lane = tid & 63, r32 = lane & 31, hi = lane >> 5, wid = __builtin_amdgcn_readfirstlane(tid >> 6);
    const int srow = tid >> 3, sch = tid & 7;
    constexpr int NU = 3 * 32 * 16;
    if (bx >= NU) return;
    u32x4 kreg[6], vreg[6]; bf16x8 qn[4];
#define DIL_LOAD(U) do { const long rb_ = (long)(U).b * SEQ; const int kb_ = 256 * (U).u - 128, j0_ = ((U).u == 0) ? 2 : 0; \
        _Pragma("unroll") for (int j = 0; j < 6; ++j) { if (j >= j0_) { const size_t ro_ = (size_t)(rb_ + (long)(kb_ + 64 * j + srow) * (U).d + (U).r) * 512 + (U).h * 64 + 8 * sch; \
            kreg[j] = *(const u32x4*)(KB + ro_); vreg[j] = *(const u32x4*)(VB + ro_); } } \
        const bf16* qp_ = QB + (size_t)(rb_ + (long)(256 * (U).u + wid * 32 + r32) * (U).d + (U).r) * 512 + (U).h * 64 + hi * 8; \
        _Pragma("unroll") for (int d0 = 0; d0 < 4; ++d0) qn[d0] = *(const bf16x8*)(qp_ + d0 * 16); } while (0)
    DilU U = dil_decode(bx);
    DIL_LOAD(U);
    const bf16x8 qx = (bf16x8){0, 0, 0, 0, 0, 0, 0, 0};
    for (int id = bx; id < NU; id += G) {
        const int j0 = (U.u == 0) ? 2 : 0;
#pragma unroll
        for (int j = 0; j < 6; ++j) { if (j >= j0) { *(LAS u32x4*)(lds + (64 * j + srow) * 144 + sch * 16) = kreg[j]; *(LAS u32x4*)(lds + DL_V + (64 * j + srow) * A_VP + sch * 16) = vreg[j]; } }
        bf16x8 qr[4];
#pragma unroll
        for (int d0 = 0; d0 < 4; ++d0) qr[d0] = qn[d0];
        __syncthreads();
        const DilU C = U;
        if (id + G < NU) { U = dil_decode(id + G); DIL_LOAD(U); }
        AttnAcc st; attn_init(st);
        const int kbase = 256 * C.u - 128, qlo = 256 * C.u + wid * 32, qs = qlo + r32;
#pragma unroll 1
        for (int j = j0; j < 6; ++j) {
            const int k0 = kbase + 64 * j;
            if (k0 + 63 >= qlo - 128 && k0 <= qlo + 31)
                attn_tile<2, false>(st, qr, qx, lds + j * (64 * 144), lds + DL_V + j * (64 * A_VP), r32, hi, lane, qs, k0, true);
        }
        const long qrow = (long)C.b * SEQ + (long)qs * C.d + C.r;
        attn_finish(st, OD + ((size_t)C.g * T + qrow) * 512 + C.h * 64, hi, LSE + ((size_t)C.g * T + qrow) * NH + C.h);
        __syncthreads();
    }
#undef DIL_LOAD
}

#define XB_TMO      128
#define XB_XCNT(j)  (256  + 64 * (j))
#define XB_XSUB(j)  (1280 + 64 * (j))
#define XB_XGEN(j)  (2304 + 64 * (j))
#define XB_TOP      3328
#define XB_TOPGEN   3392
#define XCD_BAR_WORDS 3456
#define XB_SPIN_CAP (1u << 22)
__device__ __forceinline__ unsigned xb_ld(unsigned* p)              { return __hip_atomic_load(p, __ATOMIC_RELAXED, __HIP_MEMORY_SCOPE_AGENT); }
__device__ __forceinline__ unsigned xb_add(unsigned* p, unsigned v) { return __hip_atomic_fetch_add(p, v, __ATOMIC_RELAXED, __HIP_MEMORY_SCOPE_AGENT); }
__device__ __forceinline__ unsigned xb_xcc_id() { return (unsigned)__builtin_amdgcn_s_getreg((3 << 11) | 20) & 0xFu; }
#define XB_SPIN(cond, bar) do { unsigned _sp = 0; while (cond) { __builtin_amdgcn_s_sleep(1); \
    if ((++_sp & 255u) == 0u) { if (xb_ld(&(bar)[XB_TMO])) break; if (_sp > XB_SPIN_CAP) { atomicAdd(&(bar)[XB_TMO], 1u); break; } } } } while (0)
struct XcdBarrier { unsigned* bar; unsigned x; volatile LAS unsigned* st; };
__device__ __forceinline__ XcdBarrier xcd_barrier_post(unsigned* bar, volatile LAS unsigned* st) {
    XcdBarrier b; b.bar = bar; b.x = xb_xcc_id(); b.st = st;
    if (threadIdx.x == 0) (void)xb_add(&bar[XB_XCNT(b.x)], 1u);
    return b;
}
__device__ __forceinline__ void xcd_barrier_complete(unsigned* bar, unsigned x, unsigned& nloc, unsigned& nx) {
    const unsigned G = gridDim.x * gridDim.y * gridDim.z;
    unsigned sum, cnt, mine, sp = 0u;
    for (;;) {
        sum = 0u; cnt = 0u; mine = 0u;
#pragma unroll
        for (unsigned j = 0; j < 16; ++j) { const unsigned c = xb_ld(&bar[XB_XCNT(j)]); sum += c; cnt += (c > 0u) ? 1u : 0u; mine = (j == x) ? c : mine; }
        if (sum == G) break;
        __builtin_amdgcn_s_sleep(1);
        if ((++sp & 255u) == 0u) { if (xb_ld(&bar[XB_TMO])) break; if (sp > XB_SPIN_CAP) { atomicAdd(&bar[XB_TMO], 1u); break; } }
    }
    nloc = mine > 0u ? mine : 1u; nx = cnt > 0u ? cnt : 1u;
}
__device__ __forceinline__ void xcd_barrier(const XcdBarrier& b) {
    asm volatile("s_waitcnt vmcnt(0)" ::: "memory");
    __syncthreads();
    if (threadIdx.x == 0) {
        unsigned* bar = b.bar;
        __builtin_amdgcn_s_waitcnt(0);
        unsigned nloc = b.st[0], nx = b.st[1];
        if (nloc == 0u) { xcd_barrier_complete(bar, b.x, nloc, nx); b.st[0] = nloc; b.st[1] = nx; }
        const unsigned old = xb_add(&bar[XB_XSUB(b.x)], 1u);
        const unsigned gen = old / nloc;
        if (old + 1u == (gen + 1u) * nloc) {
            __builtin_amdgcn_fence(__ATOMIC_RELEASE, "agent");
            asm volatile("s_waitcnt vmcnt(0)" ::: "memory");
            const unsigned og = xb_add(&bar[XB_TOP], 1u);
            const unsigned tg = og / nx;
            if (og + 1u == (tg + 1u) * nx) xb_add(&bar[XB_TOPGEN], 1u);
            else XB_SPIN(xb_ld(&bar[XB_TOPGEN]) == tg, bar);
            __builtin_amdgcn_fence(__ATOMIC_ACQUIRE, "agent");
            xb_add(&bar[XB_XGEN(b.x)], 1u);
            asm volatile("s_waitcnt vmcnt(0)" ::: "memory");
        } else {
            XB_SPIN(xb_ld(&bar[XB_XGEN(b.x)]) == gen, bar);
            __builtin_amdgcn_fence(__ATOMIC_ACQUIRE, "agent");
            asm volatile("s_waitcnt vmcnt(0)" ::: "memory");
        }
    }
    __syncthreads();
}

struct Args {
    const float* in[14]; float* out; unsigned char* ws; double invf[8]; int ph_lo, ph_hi; int coop, li;
};

__device__ __forceinline__ void p0_transpose_item(const float* W, int ldw, int k0, int c0, bf16* WT, int ldt, int drow0, int dk0, LAS float* scr, int lane) {
    float tmp[32];
#pragma unroll
    for (int i = 0; i < 32; ++i) { const int kk = 2 * i + (lane >> 5); tmp[i] = __builtin_nontemporal_load(&W[(size_t)(k0 + kk) * ldw + c0 + (lane & 31)]); }
#pragma unroll
    for (int i = 0; i < 32; ++i) { const int kk = 2 * i + (lane >> 5); scr[kk * 33 + (lane & 31)] = tmp[i]; }
    asm volatile("s_waitcnt lgkmcnt(0)" ::: "memory");
    const int c = lane & 7;
#pragma unroll
    for (int j = 0; j < 4; ++j) { const int n = (lane >> 3) + 8 * j; const LAS float* s = scr + (8 * c) * 33 + n;
        u32x4 o; o.x = cvt_pk_bf16(s[0 * 33], s[1 * 33]); o.y = cvt_pk_bf16(s[2 * 33], s[3 * 33]); o.z = cvt_pk_bf16(s[4 * 33], s[5 * 33]); o.w = cvt_pk_bf16(s[6 * 33], s[7 * 33]);
        *(u32x4*)(WT + (size_t)(drow0 + n) * ldt + dk0 + 8 * c) = o; }
    asm volatile("s_waitcnt lgkmcnt(0)" ::: "memory");
}

__global__ void __launch_bounds__(NTHR, 2) mega_fwd(Args args) {
    extern __shared__ __attribute__((aligned(16))) unsigned char lds_raw[];
    LAS unsigned char* lds = (LAS unsigned char*)lds_raw;
    const int tid = threadIdx.x, lane = tid & 63, wave = __builtin_amdgcn_readfirstlane(tid >> 6);
    const int G = gridDim.x, bx = blockIdx.x;
    const int gw = bx * NWAVES + wave, NGW = G * NWAVES;
    unsigned char* ws = args.ws;
    const float* x = args.in[0]; const float* g_pre_mix = args.in[1]; const float* w_in = args.in[2]; const float* b_forget = args.in[3];
    const float* w_o_fox = args.in[4]; const float* w_o_dil = args.in[5]; const float* w_out = args.in[6]; const float* g_post_mix = args.in[7];
    const float* g_pre_ffn = args.in[8]; const float* w_up = args.in[9]; const float* conv_w = args.in[10]; const float* conv_b = args.in[11];
    const float* w_down = args.in[12]; const float* g_post_ffn = args.in[13];
    float* out = args.out;
    float* cosT = (float*)(ws + WS_COS); float* sinT = (float*)(ws + WS_SIN); float* LOGF = (float*)(ws + WS_LOGF); float* Fc = (float*)(ws + WS_F); float* LSE = (float*)(ws + WS_LSE);
    bf16* WIN_T = (bf16*)(ws + WS_WIN); bf16* WO_T = (bf16*)(ws + WS_WO); bf16* WOUT_T = (bf16*)(ws + WS_WOUT); bf16* WUP_T = (bf16*)(ws + WS_WUP); bf16* WDN_T = (bf16*)(ws + WS_WDN);
    bf16* QKV = (bf16*)(ws + WS_QKV); bf16* SGA = (bf16*)(ws + WS_SGA); bf16* SGB = (bf16*)(ws + WS_SGB); bf16* Hn = (bf16*)(ws + WS_H);
    bf16* OD = (bf16*)(ws + WS_OD); bf16* O2 = (bf16*)((unsigned char*)out + 32 * MiB);    bf16* H2 = (bf16*)(ws + WS_H2); bf16* MF = (bf16*)(ws + WS_M);
    bf16* MIXED = (bf16*)(ws + WS_MIXED);
    const int lo = args.ph_lo, hi_ph = args.ph_hi;
#define IN(k) (lo <= (k) && (k) < hi_ph)
    ((volatile LAS unsigned*)(lds + RING_BYTES))[tid & 63] = 0u;
    __syncthreads();
    XcdBarrier xbar; xbar.bar = (unsigned*)(ws + WS_BAR) + args.li * XCD_BAR_WORDS; xbar.x = 0; xbar.st = nullptr;
    if (args.coop == 1) xbar = xcd_barrier_post((unsigned*)(ws + WS_BAR) + args.li * XCD_BAR_WORDS, (volatile LAS unsigned*)(lds + RING_BYTES));
#define SEAM(k) do { if (IN(k) && IN((k) + 1)) { if (args.coop == 2) { __threadfence(); cg::this_grid().sync(); } else xcd_barrier(xbar); } } while (0)

    if (IN(0)) {
        LAS float* scr = (LAS float*)(lds + wave * 9216);
        LAS float* wfl = (LAS float*)(lds + 73728);
        for (int k = tid; k < D; k += NTHR) {
#pragma unroll
            for (int j = 0; j < 8; ++j) wfl[j * 1024 + k] = w_in[(size_t)k * INW + 1536 + j];
        }
        constexpr int I_IN = 16 * 160, I_OA = 8 * 32, I_OUT = 16 * 32, I_UP = 16 * 176, I_DN = 44 * 32;
        constexpr int NITEMS = I_IN + 2 * I_OA + I_OUT + I_UP + I_DN;
        for (int it = gw; it < I_IN; it += NGW) {
            int r = it;
            if (r < I_IN) { const int kb = r / 160, nb = r % 160, n0 = 32 * nb; p0_transpose_item(w_in, INW, 64 * kb, n0 + (n0 >= 1536 ? 8 : 0), WIN_T, D, n0, 64 * kb, scr, lane); continue; } r -= I_IN;
            if (r < I_OA) { const int kb = r / 32, nb = r % 32; p0_transpose_item(w_o_fox, D, 64 * kb, 32 * nb, WO_T, D, 32 * nb, 64 * kb, scr, lane); continue; } r -= I_OA;
            if (r < I_OA) { const int kb = r / 32, nb = r % 32; p0_transpose_item(w_o_dil, D, 64 * kb, 32 * nb, WO_T, D, 32 * nb, 512 + 64 * kb, scr, lane); continue; } r -= I_OA;
            if (r < I_OUT) { const int kb = r / 32, nb = r % 32; p0_transpose_item(w_out, D, 64 * kb, 32 * nb, WOUT_T, D, 32 * nb, 64 * kb, scr, lane); continue; } r -= I_OUT;
            if (r < I_UP) { const int kb = r / 176, nb = r % 176, n0 = 32 * nb, pn = n0 >> 8, i = n0 & 255; const int c0 = (i < 128) ? (128 * pn + i) : (FF + 128 * pn + i - 128);
                p0_transpose_item(w_up, NUP, 64 * kb, c0, WUP_T, D, n0, 64 * kb, scr, lane); continue; } r -= I_UP;
            { const int kb = r / 32, nb = r % 32; p0_transpose_item(w_down, D, 64 * kb, 32 * nb, WDN_T, FF, 32 * nb, 64 * kb, scr, lane); }
        }
        for (int id = bx * NTHR + tid; id < SEQ * 8; id += G * NTHR) {
            const int pos = id >> 3, i = id & 7;
            const double ang = (double)pos * args.invf[i];
            const double TWO_PI = 6.283185307179586476925286766559;
            const double kq = __builtin_rint(ang / TWO_PI);
            const double rr = (ang - kq * TWO_PI) * 0.25;
            const double r2 = rr * rr;
            double sn = rr * (1.0 + r2 * (-1.0 / 6 + r2 * (1.0 / 120 + r2 * (-1.0 / 5040 + r2 * (1.0 / 362880 + r2 * (-1.0 / 39916800 + r2 * (1.0 / 6227020800.0 + r2 * (-1.0 / 1307674368000.0))))))));
            double cs = 1.0 + r2 * (-0.5 + r2 * (1.0 / 24 + r2 * (-1.0 / 720 + r2 * (1.0 / 40320 + r2 * (-1.0 / 3628800 + r2 * (1.0 / 479001600 + r2 * (-1.0 / 87178291200.0 + r2 * (1.0 / 20922789888000.0))))))));
#pragma unroll
            for (int k2 = 0; k2 < 2; ++k2) { const double s2 = 2.0 * sn * cs, c2 = cs * cs - sn * sn; sn = s2; cs = c2; }
            cosT[id] = (float)cs; sinT[id] = (float)sn;
        }
        __syncthreads();
        {
            f32x4 wreg[8][4];
#pragma unroll
            for (int q = 0; q < 8; ++q)
#pragma unroll
                for (int j = 0; j < 4; ++j) wreg[q][j] = *((LAS const f32x4*)(wfl + q * 1024) + lane + 64 * j);
            f32x4 gg[4];
#pragma unroll
            for (int j = 0; j < 4; ++j) gg[j] = *((const f32x4*)g_pre_mix + lane + 64 * j);
            const float bfv = (lane < 8) ? b_forget[lane] : 0.f;
            f32x4 vn[4];
            if (gw < T) {
#pragma unroll
                for (int j = 0; j < 4; ++j) vn[j] = __builtin_nontemporal_load((const f32x4*)(x + (size_t)gw * D) + lane + 64 * j);
            }
            for (int m = gw; m < T; m += NGW) {
                f32x4 v[4]; float s = 0.f;
#pragma unroll
                for (int j = 0; j < 4; ++j) { v[j] = vn[j]; s += (v[j].x * v[j].x + v[j].y * v[j].y) + (v[j].z * v[j].z + v[j].w * v[j].w); }
                if (m + NGW < T) {
#pragma unroll
                    for (int j = 0; j < 4; ++j) vn[j] = __builtin_nontemporal_load((const f32x4*)(x + (size_t)(m + NGW) * D) + lane + 64 * j);
                }
                const float inv = 1.0f / sqrtf(wave_sum(s) * (1.0f / D) + RMS_EPS);
                float dot[8];
#pragma unroll
                for (int q = 0; q < 8; ++q) dot[q] = 0.f;
                unsigned long long* o8 = (unsigned long long*)(Hn + (size_t)m * D) + lane;
#pragma unroll
                for (int j = 0; j < 4; ++j) {
                    const f32x4 hv = v[j] * inv * gg[j];
                    o8[64 * j] = (unsigned long long)cvt_pk_bf16(hv.x, hv.y) | ((unsigned long long)cvt_pk_bf16(hv.z, hv.w) << 32);
#pragma unroll
                    for (int q = 0; q < 8; ++q) { const f32x4 wv = wreg[q][j]; dot[q] += (hv.x * wv.x + hv.y * wv.y) + (hv.z * wv.z + hv.w * wv.w); }
                }
#pragma unroll
                for (int q = 0; q < 8; ++q) dot[q] = wave_sum(dot[q]);
                float z = dot[0];
#pragma unroll
                for (int q = 1; q < 8; ++q) z = (lane == q) ? dot[q] : z;
                if (lane < 8) { z += bfv;
                    const float e = __expf(-fabsf(z)); LOGF[(size_t)m * 8 + lane] = fminf(z, 0.f) - log1pf(e); }
            }
        }
    }
    SEAM(0);

    if (IN(1)) {
        for (int bh = bx; bh < NB * NH; bh += G) {
            const int bb = bh >> 3, hh = bh & 7;
            const float* src = LOGF + ((size_t)bb * SEQ + 8 * tid) * 8 + hh;
            float v[8]; float sloc = 0.f;
#pragma unroll
            for (int i = 0; i < 8; ++i) { sloc += src[i * 8]; v[i] = sloc; }
            float incl = sloc;
#pragma unroll
            for (int o = 1; o < 64; o <<= 1) { const float t = __shfl_up(incl, o); if (lane >= o) incl += t; }
            LAS float* wt = (LAS float*)lds;
            if (lane == 63) wt[wave] = incl;
            __syncthreads();
            float off = 0.f;
            for (int w = 0; w < wave; ++w) off += wt[w];
            const float base = off + incl - sloc;
            float* dst = Fc + (size_t)bh * SEQ + 8 * tid;
            *(f32x4*)dst = (f32x4){base + v[0], base + v[1], base + v[2], base + v[3]};
            *(f32x4*)(dst + 4) = (f32x4){base + v[4], base + v[5], base + v[6], base + v[7]};
            __syncthreads();
        }
        pg8::Gemm g{Hn, WIN_T, D}; pg8::StaticOrder S; S.init(T / 256, NZ / 256, G, bx);
        pg8::EpiZ E{QKV, SGA, SGB, cosT, sinT, (unsigned*)(ws + WS_KH)};
        pg8::gemm_phase<pg8::EpiZ, pg8::StaticOrder>(lds, g, S, E);
    }
    SEAM(1);

    if (IN(2)) {
        const bf16* QBp = QKV + (size_t)3 * T * 512; const bf16* KBp = QKV + (size_t)4 * T * 512; const bf16* VBp = QKV + (size_t)5 * T * 512;
        dil_phase(lds, bx, G, QBp, KBp, VBp, OD, LSE);
        const bf16* QAp = QKV; const bf16* KAp = QKV + (size_t)T * 512; const bf16* VAp = QKV + (size_t)2 * T * 512;
        { unsigned* qhead = (unsigned*)(ws + WS_FQ) + args.li; LAS int* qid = (LAS int*)(lds + 48128);
          for (;;) {
              if (tid == 0) qid[0] = (int)atomicAdd(qhead, 1u);
              __syncthreads();
              const int id = qid[0];
              if (id >= 512) break;
              const int bh = id & 31;
              fox_unit(lds, bh >> 3, bh & 7, 15 - (id >> 5), QAp, KAp, VAp, Fc, O2, (const unsigned*)(ws + WS_KH));
          }
        }
        {
            constexpr int I_OA = 8 * 32, I_OUT = 16 * 32, I_UP = 16 * 176, I_DN = 44 * 32;
            constexpr int NREST = 2 * I_OA + I_OUT + I_UP + I_DN;
            __syncthreads();
            LAS float* scr = (LAS float*)(lds + wave * 9216);
            unsigned* whead = (unsigned*)(ws + WS_FQ) + 32 + args.li; LAS int* wq = (LAS int*)(lds + 8 * 9216);
            for (;;) {
                if (tid == 0) wq[0] = (int)atomicAdd(whead, 1u);
                __syncthreads();
                const int it = wq[0] * 8 + wave;
                __syncthreads();
                if (it - wave >= NREST) break;
                if (it >= NREST) continue;
                int r = it;
                if (r < I_OA) { const int kb = r / 32, nb = r % 32; p0_transpose_item(w_o_fox, D, 64 * kb, 32 * nb, WO_T, D, 32 * nb, 64 * kb, scr, lane); continue; } r -= I_OA;
                if (r < I_OA) { const int kb = r / 32, nb = r % 32; p0_transpose_item(w_o_dil, D, 64 * kb, 32 * nb, WO_T, D, 32 * nb, 512 + 64 * kb, scr, lane); continue; } r -= I_OA;
                if (r < I_OUT) { const int kb = r / 32, nb = r % 32; p0_transpose_item(w_out, D, 64 * kb, 32 * nb, WOUT_T, D, 32 * nb, 64 * kb, scr, lane); continue; } r -= I_OUT;
                if (r < I_UP) { const int kb = r / 176, nb = r % 176, n0 = 32 * nb, pn = n0 >> 8, i = n0 & 255; const int c0 = (i < 128) ? (128 * pn + i) : (FF + 128 * pn + i - 128);
                    p0_transpose_item(w_up, NUP, 64 * kb, c0, WUP_T, D, n0, 64 * kb, scr, lane); continue; } r -= I_UP;
                { const int kb = r / 32, nb = r % 32; p0_transpose_item(w_down, D, 64 * kb, 32 * nb, WDN_T, FF, 32 * nb, 64 * kb, scr, lane); }
            }
        }
    }
    SEAM(2);

    if (IN(3)) {
        pg8::StaticOrder S; S.init(T / 256, D / 256, G, bx);
        { pg8::Unit mu;
          if (S.next(0, mu)) {
            unsigned* pcnt = (unsigned*)(ws + WS_MC) + 32 * mu.pm;
            const size_t rbase = (size_t)mu.pm * 256 + 64 * mu.pn;
            for (int it0 = tid; it0 < 64 * 64; it0 += 4 * NTHR) {
                float l0[4], l1[4], l2[4]; u32x4 a[4], b[4], cc[4];
#pragma unroll
                for (int q = 0; q < 4; ++q) { const int it = it0 + q * NTHR; const size_t row = rbase + (it >> 6); const int hh = (it >> 3) & 7, c = it & 7;
                    l0[q] = LSE[row * NH + hh]; l1[q] = LSE[((size_t)T + row) * NH + hh]; l2[q] = LSE[((size_t)2 * T + row) * NH + hh];
                    const size_t off = row * 512 + hh * 64 + c * 8;
                    a[q] = __builtin_nontemporal_load((const u32x4*)(OD + off)); b[q] = __builtin_nontemporal_load((const u32x4*)(OD + (size_t)T * 512 + off)); cc[q] = __builtin_nontemporal_load((const u32x4*)(OD + (size_t)2 * T * 512 + off)); }
#pragma unroll
                for (int q = 0; q < 4; ++q) { const int it = it0 + q * NTHR; const size_t row = rbase + (it >> 6); const int hh = (it >> 3) & 7, c = it & 7;
                    const float mx = fmaxf(l0[q], fmaxf(l1[q], l2[q]));
                    float w0 = __builtin_amdgcn_exp2f(l0[q] - mx), w1 = __builtin_amdgcn_exp2f(l1[q] - mx), w2 = __builtin_amdgcn_exp2f(l2[q] - mx);
                    const float inv = 1.0f / (w0 + w1 + w2); w0 *= inv; w1 *= inv; w2 *= inv;
                    u32x4 o;
                    o.x = cvt_pk_bf16(w0 * bf_lo(a[q].x) + w1 * bf_lo(b[q].x) + w2 * bf_lo(cc[q].x), w0 * bf_hi(a[q].x) + w1 * bf_hi(b[q].x) + w2 * bf_hi(cc[q].x));
                    o.y = cvt_pk_bf16(w0 * bf_lo(a[q].y) + w1 * bf_lo(b[q].y) + w2 * bf_lo(cc[q].y), w0 * bf_hi(a[q].y) + w1 * bf_hi(b[q].y) + w2 * bf_hi(cc[q].y));
                    o.z = cvt_pk_bf16(w0 * bf_lo(a[q].z) + w1 * bf_lo(b[q].z) + w2 * bf_lo(cc[q].z), w0 * bf_hi(a[q].z) + w1 * bf_hi(b[q].z) + w2 * bf_hi(cc[q].z));
                    o.w = cvt_pk_bf16(w0 * bf_lo(a[q].w) + w1 * bf_lo(b[q].w) + w2 * bf_lo(cc[q].w), w0 * bf_hi(a[q].w) + w1 * bf_hi(b[q].w) + w2 * bf_hi(cc[q].w));
                    st_wt16(O2 + row * 1024 + 512 + hh * 64 + c * 8, o); }
            }
            asm volatile("s_waitcnt vmcnt(0)" ::: "memory");
            __syncthreads();
            if (tid == 0) {
                __hip_atomic_fetch_add(pcnt, 1u, __ATOMIC_RELAXED, __HIP_MEMORY_SCOPE_AGENT);
                unsigned sp = 0;
                while (__hip_atomic_load(pcnt, __ATOMIC_RELAXED, __HIP_MEMORY_SCOPE_AGENT) < 4u) { __builtin_amdgcn_s_sleep(2); if (++sp > (1u << 22)) break; }
                __builtin_amdgcn_fence(__ATOMIC_ACQUIRE, "agent");
                asm volatile("s_waitcnt vmcnt(0)" ::: "memory");
            }
            __syncthreads();
          }
        }
        pg8::Gemm g{O2, WO_T, D};
        pg8::EpiMix E{SGA, SGB, MIXED};
        pg8::gemm_phase<pg8::EpiMix, pg8::StaticOrder>(lds, g, S, E);
    }
    SEAM(3);

    if (IN(4)) {
        pg8::Gemm g{MIXED, WOUT_T, D}; pg8::StaticOrder S; S.init(T / 256, D / 256, G, bx);
        pg8::PanelSS st1{(unsigned*)(ws + WS_XBUF), (unsigned*)(ws + WS_CNT)};
        pg8::PanelSS st2{(unsigned*)(ws + WS_XBUF + 0x40000), (unsigned*)(ws + WS_CNT + 0x4000)};
        pg8::EpiNormA E{x, out, H2, g_post_mix, g_pre_ffn, st1, st2};
        pg8::gemm_phase<pg8::EpiNormA, pg8::StaticOrder>(lds, g, S, E);
    }
    SEAM(4);

    if (IN(5)) {
        pg8::Gemm g{H2, WUP_T, D}; pg8::StaticOrder S; S.init(67, NUP / 256, G, bx);
        pg8::EpiConvGelu E{conv_w, conv_b, MF};
        pg8::gemm_phase<pg8::EpiConvGelu, pg8::StaticOrder>(lds, g, S, E);
    }
    SEAM(5);

    if (IN(6)) {
        pg8::Gemm g{MF, WDN_T, FF}; pg8::StaticOrder S; S.init(T / 256, D / 256, G, bx);
        pg8::PanelSS st{(unsigned*)(ws + WS_XBUF + 0x80000), (unsigned*)(ws + WS_CNT + 0x8000)};
        pg8::EpiNormB E{out, out, g_post_ffn, st};
        pg8::gemm_phase<pg8::EpiNormB, pg8::StaticOrder>(lds, g, S, E);
    }
#undef IN
#undef SEAM
}

#ifndef MK_N_LAUNCHES
#define MK_N_LAUNCHES 1
#endif
constexpr int NPHASES = 7;

extern "C" void kernel_launch(void* const* d_in, const int* in_sizes, int n_in, void* d_out, int out_size, void* d_ws, size_t ws_size, hipStream_t stream) {
    static int grid = 0;
    if (grid == 0) {
        if (n_in != 14 || in_sizes[0] != T * D || out_size != T * D || ws_size < WS_NEED) {
            fprintf(stderr, "kernel_launch: unexpected shapes: n_in %d in0 %d out %d ws %zu\n", n_in, n_in > 0 ? in_sizes[0] : -1, out_size, ws_size); grid = -1; return; }
        int dev = 0, cus = 0, per_cu = 0;
        if (hipGetDevice(&dev) != hipSuccess || hipDeviceGetAttribute(&cus, hipDeviceAttributeMultiprocessorCount, dev) != hipSuccess) { fprintf(stderr, "kernel_launch: device query failed\n"); grid = -1; return; }
        if (hipFuncSetAttribute((const void*)mega_fwd, hipFuncAttributeMaxDynamicSharedMemorySize, LDS_BYTES) != hipSuccess) { fprintf(stderr, "kernel_launch: hipFuncSetAttribute failed\n"); grid = -1; return; }
        if (hipOccupancyMaxActiveBlocksPerMultiprocessor(&per_cu, (const void*)mega_fwd, NTHR, LDS_BYTES) != hipSuccess || per_cu < 1) { fprintf(stderr, "kernel_launch: occupancy query says %d\n", per_cu); per_cu = 1; }
        (void)hipGetLastError();
        grid = cus * per_cu;
        if (grid > 256) grid = 256;
        if (grid != 256) fprintf(stderr, "kernel_launch: grid %d != 256: the fused RMSNorm epilogues need 256 co-resident workgroups\n", grid);
        fprintf(stderr, "kernel_launch: grid %d (cus %d x %d)\n", grid, cus, per_cu);
    }
    if (grid < 0) return;
    if (hipMemsetAsync(d_ws, 0, WS_BAR_BYTES, stream) != hipSuccess) { fprintf(stderr, "kernel_launch: memset failed\n"); return; }
    Args a{};
    for (int i = 0; i < 14; ++i) a.in[i] = (const float*)d_in[i];
    a.out = (float*)d_out; a.ws = (unsigned char*)d_ws;
    for (int i = 0; i < 8; ++i) a.invf[i] = pow(500000.0, -(double)i / 8.0);
    a.li = 0;
#if defined(PROBE_SPLIT)
    { void* params[] = {&a}; a.coop = 1;
      a.ph_lo = 0; a.ph_hi = PROBE_SPLIT + 1; hipLaunchCooperativeKernel((const void*)mega_fwd, dim3(grid), dim3(NTHR), params, LDS_BYTES, stream);
      a.li = 1; a.ph_lo = PROBE_SPLIT + 1; a.ph_hi = NPHASES; hipLaunchCooperativeKernel((const void*)mega_fwd, dim3(grid), dim3(NTHR), params, LDS_BYTES, stream); }
#elif defined(PROBE_DUP)
    { void* params[] = {&a}; a.coop = 1;
      a.ph_lo = 0; a.ph_hi = PROBE_DUP + 1; hipLaunchCooperativeKernel((const void*)mega_fwd, dim3(grid), dim3(NTHR), params, LDS_BYTES, stream);
      a.li = 1; a.ph_lo = PROBE_DUP; a.ph_hi = PROBE_DUP + 1; hipLaunchCooperativeKernel((const void*)mega_fwd, dim3(grid), dim3(NTHR), params, LDS_BYTES, stream);
      a.li = 2; a.ph_lo = PROBE_DUP + 1; a.ph_hi = NPHASES; hipLaunchCooperativeKernel((const void*)mega_fwd, dim3(grid), dim3(NTHR), params, LDS_BYTES, stream); }
#elif MK_N_LAUNCHES == 1
    a.ph_lo = 0; a.ph_hi = NPHASES; a.coop = 1;
    void* params[] = {&a};
    hipError_t e = hipLaunchCooperativeKernel((const void*)mega_fwd, dim3(grid), dim3(NTHR), params, LDS_BYTES, stream);
    if (e != hipSuccess) fprintf(stderr, "kernel_launch: cooperative launch failed: %s (grid %d)\n", hipGetErrorString(e), grid);
#else
    for (int p = 0; p < NPHASES; ++p) {
        a.ph_lo = p; a.ph_hi = p + 1; a.coop = 0;
        hipLaunchKernelGGL(mega_fwd, dim3(grid), dim3(NTHR), LDS_BYTES, stream, a);
    }
#endif
}
```

```cpp
#include <hip/hip_runtime.h>
#include <hip/hip_cooperative_groups.h>
#include <cstdio>
#include <cstdint>
#include <cmath>
namespace cg = cooperative_groups;

#define LAS __attribute__((address_space(3)))
#define GAS __attribute__((address_space(1)))
typedef unsigned short bf16;
typedef short bf16x8 __attribute__((ext_vector_type(8)));
typedef float f32x2 __attribute__((ext_vector_type(2)));
typedef float f32x4 __attribute__((ext_vector_type(4)));
typedef float f32x16 __attribute__((ext_vector_type(16)));
typedef unsigned u32x2 __attribute__((ext_vector_type(2)));
typedef unsigned u32x4 __attribute__((ext_vector_type(4)));
typedef __bf16 bf16x2_t __attribute__((ext_vector_type(2)));

constexpr int NB = 4, SEQ = 4096, T = NB * SEQ, D = 1024, NH = 8, HD = 64;
constexpr int NZ = 5120;
constexpr int INW = 5128;
constexpr int FF = 2816, NUP = 2 * FF;
constexpr int NWAVES = 8, NTHR = NWAVES * 64;
constexpr float RMS_EPS = 1e-6f;
constexpr float LOG2E = 1.4426950408889634f;
constexpr float QSCALE = 0.125f * LOG2E;
constexpr float NEGBIG = -1e30f;

constexpr size_t MiB = 1u << 20;
constexpr size_t WS_BAR = 0, WS_CNT = 0x10000, WS_BAR_BYTES = 0x20000;
constexpr size_t WS_KH = 0x1C000, WS_FQ = 0x1D000;
constexpr size_t WS_MC = 0x1E000;
constexpr size_t WS_XBUF = 0x300000;
constexpr size_t WS_COS = 0x20000, WS_SIN = 0x40000, WS_LOGF = 0x80000, WS_F = 0x100000, WS_LSE = 0x180000;
constexpr size_t WS_WIN = 4 * MiB, WS_WO = 14 * MiB, WS_WOUT = 16 * MiB, WS_WUP = 18 * MiB, WS_WDN = 29 * MiB;
constexpr size_t WS_QKV = 36 * MiB;
constexpr size_t WS_SGA = 132 * MiB, WS_SGB = 164 * MiB;
constexpr size_t WS_H = 196 * MiB;
constexpr size_t WS_OD = 196 * MiB;
constexpr size_t WS_O2 = 84 * MiB;
constexpr size_t WS_MIXED = 36 * MiB;
constexpr size_t WS_H2 = 198 * MiB;
constexpr size_t WS_M = 100 * MiB;
constexpr size_t WS_NEED = 256 * MiB;

constexpr int RING_BYTES = 131072;
constexpr int LDS_BYTES = 135168;

__device__ __forceinline__ unsigned cvt_pk_bf16(float lo, float hi) { f32x2 v = {lo, hi}; bf16x2_t b = __builtin_convertvector(v, bf16x2_t); return __builtin_bit_cast(unsigned, b); }
__device__ __forceinline__ void st_wt16(void* p, u32x4 v) { asm volatile("global_store_dwordx4 %0, %1, off sc0 sc1\n\ts_nop 1" :: "v"(p), "v"(v) : "memory"); }
__device__ __forceinline__ float bf_lo(unsigned u) { return __uint_as_float(u << 16); }
__device__ __forceinline__ float bf_hi(unsigned u) { return __uint_as_float(u & 0xffff0000u); }
__device__ __forceinline__ float fast_sigmoid(float x) { return __builtin_amdgcn_rcpf(1.0f + __builtin_amdgcn_exp2f(-x * LOG2E)); }
template <int CTRL> __device__ __forceinline__ float dpp_f(float v) {
    return __builtin_bit_cast(float, __builtin_amdgcn_update_dpp(0, __builtin_bit_cast(int, v), CTRL, 0xF, 0xF, false));
}
__device__ __forceinline__ float wave_sum(float v) {
    v += dpp_f<0xB1>(v); v += dpp_f<0x4E>(v); v += dpp_f<0x141>(v); v += dpp_f<0x140>(v);
    v += __shfl_xor(v, 16);
    auto rr = __builtin_amdgcn_permlane32_swap(__float_as_uint(v), __float_as_uint(v), false, false);
    return __uint_as_float(rr[0]) + __uint_as_float(rr[1]);
}

namespace pg8 {
constexpr int BM = 256, BK = 64, HALF = 128, HTB = HALF * BK * 2, STAGE_BYTES = 8 * HTB, NXCD = 8, WGM = 8;
__host__ __device__ __forceinline__ int lds_byte(int r, int c) { const int st = (r >> 4) * 2 + (c >> 5), rr = r & 15, cc = c & 31, ob = rr * 64 + cc * 2; return st * 1024 + (ob ^ (((ob >> 9) & 1) << 5)); }
__host__ __device__ __forceinline__ void stage_rc(int b, int& R, int& C) { const int st = b / 1024, sb = b % 1024, swz = sb ^ (((sb >> 9) & 1) << 5); R = (st >> 1) * 16 + swz / 64; C = (st & 1) * 32 + (swz % 64) / 2; }
__host__ __device__ __forceinline__ int perm32(int rho) { const int n = rho >> 4, i = rho & 15; return 8 * (i >> 2) + 4 * n + (i & 3); }

struct Unit { int pm, pn; };
struct Gemm { const bf16* A; const bf16* Bt; int K; };

struct StaticOrder {
    int nM, nN, nwg, G, c;
    __device__ void init(int nM_, int nN_, int G_, int c_) { nM = nM_; nN = nN_; nwg = nM * nN; G = G_; c = c_; }
    __device__ bool next(int i, Unit& u) const {
        const long L = (long)i * G + c; if (L >= nwg) return false;
        int wgid = (int)L; { const int q = nwg / NXCD, r = nwg % NXCD, xcd = wgid % NXCD, off = wgid / NXCD; wgid = (xcd < r ? xcd * (q + 1) : r * (q + 1) + (xcd - r) * q) + off; }
        const int nig = WGM * nN, gid = wgid / nig, fm = gid * WGM, gsz = (nM - fm) < WGM ? (nM - fm) : WGM;
        u.pm = fm + ((wgid % nig) % gsz); u.pn = (wgid % nig) / gsz; return true;
    }
};

template <class Epi, class Sched>
__device__ __forceinline__ void gemm_phase(LAS unsigned char* lds, const Gemm g, const Sched& S, const Epi& E) {
    const int tid = threadIdx.x, wid = __builtin_amdgcn_readfirstlane(tid >> 6), lane = tid & 63, wr = wid >> 2, wc = wid & 3, fr = lane & 15, fq = lane >> 4;
    const int K = g.K, nt = K / BK;
    constexpr bool HALO = Epi::HALO;
    unsigned voffA[2], voffB[2];
#pragma unroll
    for (int i = 0; i < 2; ++i) { int R, C; stage_rc(tid * 16 + i * 8192, R, C); const int Rb = Epi::PERM ? ((R & ~31) + perm32(R & 31)) : R;
        const int Ra = HALO ? (R - 2 * (R >> 6)) : R;
        voffA[i] = (unsigned)(Ra * K + C) * 2u; voffB[i] = (unsigned)(Rb * K + C) * 2u; }
    const size_t kstep = (size_t)(BK * 2);
    const size_t hstepB = (size_t)HALF * K * 2, tstepB = 2 * hstepB;
    const size_t hstepA = (size_t)(HALO ? 124 : 128) * K * 2, tstepA = 2 * hstepA;
    const char* Abase = (const char*)g.A - (HALO ? (size_t)2 * K * 2 : (size_t)0);
    const unsigned ldsw = (unsigned)wid * 1024u;
    const int aoff = lds_byte(wr * 64 + fr, fq * 8), boff = lds_byte(wc * 32 + fr, fq * 8);
#define PG8_SA(b, h) (((b) * 2 + (h)) * HTB)
#define PG8_SB(b, h) ((4 + (b) * 2 + (h)) * HTB)
#define PG8_STAGE(bufoff, gbase, voff) do { _Pragma("unroll") for (int _i = 0; _i < 2; ++_i) \
        __builtin_amdgcn_global_load_lds((const unsigned*)((const char*)(gbase) + (voff)[_i]), (LAS unsigned*)(lds + (bufoff) + ldsw + _i * 8192), 16, 0, 0); } while (0)
#define PG8_LDA(dst, b, h) do { _Pragma("unroll") for (int m = 0; m < 4; ++m) _Pragma("unroll") for (int k = 0; k < 2; ++k) dst[m][k] = *(const LAS bf16x8*)(lds + PG8_SA(b, h) + aoff + m * 2048 + k * 1024); } while (0)
#define PG8_LDB(dst, b, h) do { _Pragma("unroll") for (int n = 0; n < 2; ++n) _Pragma("unroll") for (int k = 0; k < 2; ++k) dst[n][k] = *(const LAS bf16x8*)(lds + PG8_SB(b, h) + boff + n * 2048 + k * 1024); } while (0)
#define PG8_MMA(ai, bj, At, Bt) do { __builtin_amdgcn_s_setprio(1); _Pragma("unroll") for (int m = 0; m < 4; ++m) _Pragma("unroll") for (int n = 0; n < 2; ++n) _Pragma("unroll") for (int k = 0; k < 2; ++k) \
        acc[ai][bj][m][n] = __builtin_amdgcn_mfma_f32_16x16x32_bf16(Bt[n][k], At[m][k], acc[ai][bj][m][n], 0, 0, 0); __builtin_amdgcn_s_setprio(0); } while (0)
#define PG8_WAIT_V(n) asm volatile("s_waitcnt vmcnt(" #n ")" ::: "memory")
#define PG8_WAIT_L(n) asm volatile("s_waitcnt lgkmcnt(" #n ")" ::: "memory")
#define PG8_BAR __builtin_amdgcn_s_barrier()
#define PG8_SCHED __builtin_amdgcn_sched_barrier(0)
    Unit cur, nxt; int ui = 0;
    if (!S.next(0, cur)) return;
    f32x4 acc[2][2][4][2];
#pragma unroll
    for (int a = 0; a < 2; ++a)
#pragma unroll
        for (int b = 0; b < 2; ++b)
#pragma unroll
            for (int m = 0; m < 4; ++m)
#pragma unroll
                for (int n = 0; n < 2; ++n) acc[a][b][m][n] = (f32x4){0.f, 0.f, 0.f, 0.f};
    bf16x8 At[4][2], B0[2][2], B1[2][2];
    const char* cA = Abase + (size_t)cur.pm * tstepA; const char* cB = (const char*)g.Bt + (size_t)cur.pn * tstepB;
    PG8_STAGE(PG8_SB(0, 0), cB, voffB); PG8_STAGE(PG8_SB(0, 1), cB + hstepB, voffB); PG8_STAGE(PG8_SA(0, 0), cA, voffA); PG8_STAGE(PG8_SA(0, 1), cA + hstepA, voffA);
    if (wr == 1) PG8_BAR;
    PG8_WAIT_V(2); PG8_BAR;
    PG8_STAGE(PG8_SB(1, 0), cB + kstep, voffB); PG8_STAGE(PG8_SA(1, 0), cA + kstep, voffA); PG8_STAGE(PG8_SB(1, 1), cB + hstepB + kstep, voffB);
    PG8_WAIT_V(6); PG8_BAR;
    for (;;) {
        const bool has_next = S.next(ui + 1, nxt);
        const char* nA = has_next ? Abase + (size_t)nxt.pm * tstepA : cA; const char* nB = has_next ? (const char*)g.Bt + (size_t)nxt.pn * tstepB : cB;
        for (int t = 0; t < nt; t += 2) {
            if constexpr (Epi::HAS_MID) { if (t == (nt >> 1)) E.mid(acc, cur, wr, wc, fr, fq); }
            const bool last = (t == nt - 2);
            const char* a1 = cA + (size_t)(t + 1) * kstep;
            const char* a2 = last ? nA : cA + (size_t)(t + 2) * kstep; const char* b2 = last ? nB : cB + (size_t)(t + 2) * kstep;
            const char* a3 = a2 + kstep; const char* b3 = b2 + kstep;
            PG8_LDB(B0, 0, 0); PG8_LDB(B1, 0, 1); PG8_SCHED; PG8_LDA(At, 0, 0); PG8_STAGE(PG8_SA(1, 1), a1 + hstepA, voffA);
            PG8_WAIT_V(8); PG8_WAIT_L(0); PG8_BAR; PG8_MMA(0, 0, At, B0); PG8_MMA(0, 1, At, B1); PG8_BAR; PG8_SCHED;
            PG8_LDA(At, 0, 1); PG8_STAGE(PG8_SB(0, 0), b2, voffB); PG8_STAGE(PG8_SB(0, 1), b2 + hstepB, voffB); PG8_STAGE(PG8_SA(0, 0), a2, voffA);
            PG8_WAIT_V(8); PG8_WAIT_L(0); PG8_BAR; PG8_MMA(1, 0, At, B0); PG8_MMA(1, 1, At, B1); PG8_BAR; PG8_SCHED;
            PG8_LDB(B0, 1, 0); PG8_LDB(B1, 1, 1); PG8_SCHED; PG8_LDA(At, 1, 0); PG8_STAGE(PG8_SA(0, 1), a2 + hstepA, voffA);
            PG8_WAIT_V(8); PG8_WAIT_L(0); PG8_BAR; PG8_MMA(0, 0, At, B0); PG8_MMA(0, 1, At, B1); PG8_BAR; PG8_SCHED;
            PG8_LDA(At, 1, 1); PG8_STAGE(PG8_SB(1, 0), b3, voffB); PG8_STAGE(PG8_SB(1, 1), b3 + hstepB, voffB); PG8_STAGE(PG8_SA(1, 0), a3, voffA);
            PG8_WAIT_V(8); PG8_WAIT_L(0); PG8_BAR; PG8_MMA(1, 0, At, B0); PG8_MMA(1, 1, At, B1); PG8_BAR; PG8_SCHED;
        }
        if (wr == 0) PG8_BAR;
        if constexpr (!Epi::AFTER_DRAIN) E(acc, cur, wr, wc, fr, fq);
        if (!has_next) break;
#pragma unroll
        for (int a = 0; a < 2; ++a)
#pragma unroll
            for (int b = 0; b < 2; ++b)
#pragma unroll
                for (int m = 0; m < 4; ++m)
#pragma unroll
                    for (int n = 0; n < 2; ++n) acc[a][b][m][n] = (f32x4){0.f, 0.f, 0.f, 0.f};
        cur = nxt; cA = nA; cB = nB; ++ui;
        if (wr == 1) PG8_BAR;
    }
    PG8_WAIT_V(0);
    PG8_BAR;
    if constexpr (Epi::AFTER_DRAIN) E.fused(acc, cur, wr, wc, fr, fq, lds, wid, lane);
#undef PG8_SA
#undef PG8_SB
#undef PG8_STAGE
#undef PG8_LDA
#undef PG8_LDB
#undef PG8_MMA
#undef PG8_WAIT_V
#undef PG8_WAIT_L
#undef PG8_BAR
#undef PG8_SCHED
}

struct EpiZ {
    static constexpr bool PERM = true, HALO = false, HAS_MID = false, AFTER_DRAIN = false;
    bf16* qkv; bf16* sga; bf16* sgb; const float* cosT; const float* sinT; unsigned* kh;
    __device__ __forceinline__ void mid(f32x4 (&)[2][2][4][2], const Unit&, int, int, int, int) const {}
    __device__ __forceinline__ void operator()(f32x4 (&acc)[2][2][4][2], const Unit& u, int wr, int wc, int fr, int fq) const {
        if ((u.pn >> 1) == 1) {
#pragma unroll
            for (int bj = 0; bj < 2; ++bj) {
                float mx = 0.f;
#pragma unroll
                for (int ai = 0; ai < 2; ++ai)
#pragma unroll
                    for (int m = 0; m < 4; ++m) { const f32x4 a = acc[ai][bj][m][0], b = acc[ai][bj][m][1];
                        float q = ((a[0] * a[0] + a[1] * a[1]) + (a[2] * a[2] + a[3] * a[3])) + ((b[0] * b[0] + b[1] * b[1]) + (b[2] * b[2] + b[3] * b[3]));
                        q += __shfl_xor(q, 16); q += __shfl_xor(q, 32); mx = fmaxf(mx, q); }
                mx = fmaxf(mx, __shfl_xor(mx, 1)); mx = fmaxf(mx, __shfl_xor(mx, 2)); mx = fmaxf(mx, __shfl_xor(mx, 4)); mx = fmaxf(mx, __shfl_xor(mx, 8));
                if (fr == 0 && fq == 0) { const int head = ((u.pn & 1) * 256 + bj * 128 + wc * 32) >> 6, bb = (u.pm * 256) / SEQ;
                    atomicMax(kh + (bb * NH + head) * 2 + (wc & 1), __float_as_uint(mx)); }
            }
        }
        const int pn = u.pn; bf16* base; int ldc, colt, mode;
        if (pn < 12) { const int reg = pn >> 1; base = qkv + (size_t)reg * T * 512; ldc = 512; colt = (pn & 1) * 256; mode = (reg == 0) ? 1 : (reg == 3) ? 3 : (reg == 4) ? 2 : 0; }
        else if (pn < 16) { base = sga; ldc = 1024; colt = (pn - 12) * 256; mode = 4; }
        else { base = sgb; ldc = 1024; colt = (pn - 16) * 256; mode = 4; }
        const int row0 = u.pm * 256 + wr * 64 + fr, col0 = colt + wc * 32 + 8 * fq;
        const bool rope = (mode & 2) && ((wc & 1) == 0);
        const float sc = (mode & 1) ? QSCALE : 1.0f;
        const float sgn = (fq == 0) ? -1.0f : 1.0f;
        if (rope) {
#pragma unroll
            for (int ai = 0; ai < 2; ++ai)
#pragma unroll
                for (int m = 0; m < 4; ++m) {
                    const int pos = (row0 + ai * 128 + m * 16) & (SEQ - 1);
                    const f32x4 cs0 = *(const f32x4*)(cosT + pos * 8), cs1 = *(const f32x4*)(cosT + pos * 8 + 4), sn0 = *(const f32x4*)(sinT + pos * 8), sn1 = *(const f32x4*)(sinT + pos * 8 + 4);
#pragma unroll
                    for (int bj = 0; bj < 2; ++bj) {
                        f32x4 v0 = acc[ai][bj][m][0], v1 = acc[ai][bj][m][1], p0, p1;
#pragma unroll
                        for (int j = 0; j < 4; ++j) { p0[j] = __shfl_xor(v0[j], 16); p1[j] = __shfl_xor(v1[j], 16); }
                        if (fq < 2) {
#pragma unroll
                            for (int j = 0; j < 4; ++j) { v0[j] = v0[j] * cs0[j] + sgn * p0[j] * sn0[j]; v1[j] = v1[j] * cs1[j] + sgn * p1[j] * sn1[j]; }
                        }
                        acc[ai][bj][m][0] = v0; acc[ai][bj][m][1] = v1;
                    }
                }
        }
#pragma unroll
        for (int ai = 0; ai < 2; ++ai)
#pragma unroll
            for (int m = 0; m < 4; ++m) {
                const int row = row0 + ai * 128 + m * 16;
                bf16* rowp = base + (size_t)row * ldc + col0;
#pragma unroll
                for (int bj = 0; bj < 2; ++bj) {
                    f32x4 v0 = acc[ai][bj][m][0], v1 = acc[ai][bj][m][1];
                    if (mode == 4) {
#pragma unroll
                        for (int j = 0; j < 4; ++j) { v0[j] = fast_sigmoid(v0[j]); v1[j] = fast_sigmoid(v1[j]); }
                    } else {
                        v0 = v0 * sc; v1 = v1 * sc;
                    }
                    u32x4 w; w.x = cvt_pk_bf16(v0[0], v0[1]); w.y = cvt_pk_bf16(v0[2], v0[3]); w.z = cvt_pk_bf16(v1[0], v1[1]); w.w = cvt_pk_bf16(v1[2], v1[3]);
                    *(u32x4*)(rowp + bj * 128) = w;
                }
            }
    }
};

struct EpiMix {
    static constexpr bool PERM = true, HALO = false, HAS_MID = true, AFTER_DRAIN = false;
    const bf16* sga; const bf16* sgb; bf16* out;
    __device__ __forceinline__ void mid(f32x4 (&acc)[2][2][4][2], const Unit& u, int wr, int wc, int fr, int fq) const {
        unsigned opq; asm volatile("v_mov_b32 %0, 0" : "=v"(opq));
        const unsigned base = (unsigned)((u.pm * 256 + wr * 64 + fr) * D + u.pn * 256 + wc * 32 + 8 * fq) * 2u + opq;
#pragma unroll
        for (int ai = 0; ai < 2; ++ai)
#pragma unroll
            for (int m = 0; m < 4; ++m) {
                const unsigned off = base + (unsigned)((ai * 128 + m * 16) * D) * 2u;
#pragma unroll
                for (int bj = 0; bj < 2; ++bj) {
                    const u32x4 a = __builtin_nontemporal_load((const u32x4*)((const char*)sga + (off + bj * 256))), b = *(const u32x4*)((const char*)sgb + (off + bj * 256));
                    f32x4 r0, r1;
                    r0[0] = bf_lo(a.x) * __builtin_amdgcn_rcpf(bf_lo(b.x)); r0[1] = bf_hi(a.x) * __builtin_amdgcn_rcpf(bf_hi(b.x));
                    r0[2] = bf_lo(a.y) * __builtin_amdgcn_rcpf(bf_lo(b.y)); r0[3] = bf_hi(a.y) * __builtin_amdgcn_rcpf(bf_hi(b.y));
                    r1[0] = bf_lo(a.z) * __builtin_amdgcn_rcpf(bf_lo(b.z)); r1[1] = bf_hi(a.z) * __builtin_amdgcn_rcpf(bf_hi(b.z));
                    r1[2] = bf_lo(a.w) * __builtin_amdgcn_rcpf(bf_lo(b.w)); r1[3] = bf_hi(a.w) * __builtin_amdgcn_rcpf(bf_hi(b.w));
                    acc[ai][bj][m][0] = acc[ai][bj][m][0] * r0; acc[ai][bj][m][1] = acc[ai][bj][m][1] * r1;
                }
                if (m == 3) asm volatile("" ::: "memory");
            }
    }
    __device__ __forceinline__ void operator()(f32x4 (&acc)[2][2][4][2], const Unit& u, int wr, int wc, int fr, int fq) const {
        const int row0 = u.pm * 256 + wr * 64 + fr, col0 = u.pn * 256 + wc * 32 + 8 * fq;
#pragma unroll
        for (int ai = 0; ai < 2; ++ai)
#pragma unroll
            for (int m = 0; m < 4; ++m) {
                const size_t off = (size_t)(row0 + ai * 128 + m * 16) * D + col0;
#pragma unroll
                for (int bj = 0; bj < 2; ++bj) {
                    const u32x4 b = __builtin_nontemporal_load((const u32x4*)(sgb + off + bj * 128));
                    const f32x4 v0 = acc[ai][bj][m][0], v1 = acc[ai][bj][m][1];
                    u32x4 w;
                    w.x = cvt_pk_bf16(v0[0] * bf_lo(b.x), v0[1] * bf_hi(b.x)); w.y = cvt_pk_bf16(v0[2] * bf_lo(b.y), v0[3] * bf_hi(b.y));
                    w.z = cvt_pk_bf16(v1[0] * bf_lo(b.z), v1[1] * bf_hi(b.z)); w.w = cvt_pk_bf16(v1[2] * bf_lo(b.w), v1[3] * bf_hi(b.w));
                    *(u32x4*)(out + off + bj * 128) = w;
                }
                if (m == 3) asm volatile("" ::: "memory");
            }
    }
};

struct EpiF32 {
    static constexpr bool PERM = false, HALO = false, HAS_MID = false, AFTER_DRAIN = false;
    float* out;
    __device__ __forceinline__ void mid(f32x4 (&)[2][2][4][2], const Unit&, int, int, int, int) const {}
    __device__ __forceinline__ void operator()(f32x4 (&acc)[2][2][4][2], const Unit& u, int wr, int wc, int fr, int fq) const {
        const int row0 = u.pm * 256 + wr * 64 + fr, col0 = u.pn * 256 + wc * 32 + 4 * fq;
#pragma unroll
        for (int ai = 0; ai < 2; ++ai)
#pragma unroll
            for (int m = 0; m < 4; ++m) {
                float* rowp = out + (size_t)(row0 + ai * 128 + m * 16) * D + col0;
#pragma unroll
                for (int bj = 0; bj < 2; ++bj)
#pragma unroll
                    for (int n = 0; n < 2; ++n) *(f32x4*)(rowp + bj * 128 + n * 16) = acc[ai][bj][m][n];
            }
    }
};

template <int CTRL> __device__ __forceinline__ float dpp0_f(float v) {
    return __builtin_bit_cast(float, __builtin_amdgcn_update_dpp(0, __builtin_bit_cast(int, v), CTRL, 0xF, 0xF, true));
}
struct EpiConvGelu {
    static constexpr bool PERM = true, HALO = true, HAS_MID = false, AFTER_DRAIN = false;
    const float* cw; const float* cb; bf16* out;
    __device__ __forceinline__ void mid(f32x4 (&)[2][2][4][2], const Unit&, int, int, int, int) const {}
    __device__ __forceinline__ void operator()(f32x4 (&acc)[2][2][4][2], const Unit& u, int wr, int wc, int fr, int fq) const {
        const int ca0 = u.pn * 128 + wc * 32 + 8 * fq;
        const float f0 = (fr == 0) ? 1.0f : 0.0f, f1 = (fr < 2) ? 1.0f : 0.0f;
        constexpr float GC1 = -1.5957691216057308f * LOG2E, GC2 = GC1 * 0.044715f;
#pragma unroll
        for (int n = 0; n < 2; ++n) {
            const int ca = ca0 + 4 * n;
            const f32x4 wa0 = *(const f32x4*)(cw + ca), wa1 = *(const f32x4*)(cw + NUP + ca), wa2 = *(const f32x4*)(cw + 2 * NUP + ca), ba = *(const f32x4*)(cb + ca);
            const f32x4 wb0 = *(const f32x4*)(cw + FF + ca), wb1 = *(const f32x4*)(cw + NUP + FF + ca), wb2 = *(const f32x4*)(cw + 2 * NUP + FF + ca), bb = *(const f32x4*)(cb + FF + ca);
#pragma unroll
            for (int ai = 0; ai < 2; ++ai) {
                const int s = 2 * ai + wr;
#pragma unroll
                for (int m = 0; m < 4; ++m) {
                    const int li = 16 * m + fr; const int grow = u.pm * 248 + 62 * s + li - 2;
                    const int tpos = grow & (SEQ - 1);
                    const int mp = (m > 0) ? m - 1 : 0;
                    float p1a[4], p2a[4], p1b[4], p2b[4];
#pragma unroll
                    for (int j = 0; j < 4; ++j) {
                        const float xa = acc[ai][0][m][n][j], xb = acc[ai][1][m][n][j], xap = acc[ai][0][mp][n][j], xbp = acc[ai][1][mp][n][j];
                        p1a[j] = dpp_f<0x121>(xap) * f0 + dpp0_f<0x111>(xa); p2a[j] = dpp_f<0x122>(xap) * f1 + dpp0_f<0x112>(xa);
                        p1b[j] = dpp_f<0x121>(xbp) * f0 + dpp0_f<0x111>(xb); p2b[j] = dpp_f<0x122>(xbp) * f1 + dpp0_f<0x112>(xb);
                    }
                    if (__any((int)(tpos < 2))) {
                        const float k1 = (tpos >= 1) ? 1.0f : 0.0f, k2 = (tpos >= 2) ? 1.0f : 0.0f;
#pragma unroll
                        for (int j = 0; j < 4; ++j) { p1a[j] *= k1; p2a[j] *= k2; p1b[j] *= k1; p2b[j] *= k2; }
                    }
                    float o[4];
#pragma unroll
                    for (int j = 0; j < 4; ++j) {
                        const float xa = acc[ai][0][m][n][j], xb = acc[ai][1][m][n][j];
                        const float va = wa0[j] * p2a[j] + (wa1[j] * p1a[j] + (wa2[j] * xa + ba[j]));
                        const float vb = wb0[j] * p2b[j] + (wb1[j] * p1b[j] + (wb2[j] * xb + bb[j]));
                        const float e = __builtin_amdgcn_exp2f(va * (GC1 + GC2 * (va * va)));
                        o[j] = va * vb * __builtin_amdgcn_rcpf(1.0f + e);
                    }
                    if (li >= 2 && grow < T) { u32x2 w; w.x = cvt_pk_bf16(o[0], o[1]); w.y = cvt_pk_bf16(o[2], o[3]); *(u32x2*)(out + (size_t)grow * FF + ca) = w; }
                }
            }
        }
    }
};

struct PanelSS {
    unsigned* xbuf;
    unsigned* cnt;
    __device__ __forceinline__ void run(const f32x4 (&v)[2][2][4][2], const Unit& u, int wr, int wc, int fr, int fq, LAS unsigned char* lds, int wid, int lane) const {
        LAS float* P = (LAS float*)lds;
        LAS float* S = (LAS float*)(lds + 4096);
#pragma unroll
        for (int ai = 0; ai < 2; ++ai)
#pragma unroll
            for (int m = 0; m < 4; ++m) {
                float q = 0.f;
#pragma unroll
                for (int bj = 0; bj < 2; ++bj)
#pragma unroll
                    for (int n = 0; n < 2; ++n) { const f32x4 x = v[ai][bj][m][n]; q += (x[0] * x[0] + x[1] * x[1]) + (x[2] * x[2] + x[3] * x[3]); }
                q += __shfl_xor(q, 16); q += __shfl_xor(q, 32);
                if (fq == 0) P[(ai * 128 + wr * 64 + m * 16 + fr) * 4 + wc] = q;
            }
        asm volatile("s_waitcnt lgkmcnt(0)" ::: "memory"); __builtin_amdgcn_s_barrier(); asm volatile("" ::: "memory");
        const int row = wid * 32 + (lane & 31);
        if (lane < 32) {
            const float t = (P[row * 4 + 0] + P[row * 4 + 1]) + (P[row * 4 + 2] + P[row * 4 + 3]);
            __hip_atomic_store(xbuf + ((size_t)(u.pm * 256 + row) * 4 + u.pn), __float_as_uint(t), __ATOMIC_RELAXED, __HIP_MEMORY_SCOPE_AGENT);
        }
        asm volatile("s_waitcnt vmcnt(0)" ::: "memory");
        if (lane == 0) __hip_atomic_fetch_add(cnt + 64 * u.pm, 1u, __ATOMIC_RELAXED, __HIP_MEMORY_SCOPE_AGENT);
        if (wid == 0) {
            unsigned sp = 0;
            for (;;) {
                if ((unsigned)__builtin_amdgcn_readfirstlane(__hip_atomic_load(cnt + 64 * u.pm, __ATOMIC_RELAXED, __HIP_MEMORY_SCOPE_AGENT)) >= 32u) break;
                if (++sp > (1u << 22)) break;
                __builtin_amdgcn_s_sleep(2);
            }
            __builtin_amdgcn_fence(__ATOMIC_ACQUIRE, "agent");
        }
        asm volatile("s_waitcnt vmcnt(0) lgkmcnt(0)" ::: "memory"); __builtin_amdgcn_s_barrier(); asm volatile("" ::: "memory");
        if (lane < 32) {
            const unsigned* slot = xbuf + (size_t)(u.pm * 256 + row) * 4; float t = 0.f;
#pragma unroll
            for (int k = 0; k < 4; ++k) t += __uint_as_float(__hip_atomic_load(slot + k, __ATOMIC_RELAXED, __HIP_MEMORY_SCOPE_AGENT));
            S[row] = 1.0f / sqrtf(t * (1.0f / 1024.0f) + RMS_EPS);
        }
        asm volatile("s_waitcnt lgkmcnt(0)" ::: "memory"); __builtin_amdgcn_s_barrier(); asm volatile("" ::: "memory");
    }
};
struct EpiNormA {
    static constexpr bool PERM = false, HALO = false, HAS_MID = false, AFTER_DRAIN = true;
    const float* x; float* out; bf16* h2; const float* g1; const float* g2; PanelSS st1, st2;
    __device__ __forceinline__ void mid(f32x4 (&)[2][2][4][2], const Unit&, int, int, int, int) const {}
    __device__ __forceinline__ void fused(f32x4 (&acc)[2][2][4][2], const Unit& u, int wr, int wc, int fr, int fq, LAS unsigned char* lds, int wid, int lane) const {
        const LAS float* S = (const LAS float*)(lds + 4096);
        const int col0 = u.pn * 256 + wc * 32 + 4 * fq;
        f32x4 pre[4][2][2];
#pragma unroll
        for (int m = 0; m < 4; ++m) { const size_t off = (size_t)(u.pm * 256 + wr * 64 + m * 16 + fr) * D + col0;
#pragma unroll
            for (int bj = 0; bj < 2; ++bj)
#pragma unroll
                for (int n = 0; n < 2; ++n) pre[m][bj][n] = __builtin_nontemporal_load((const f32x4*)(x + off + bj * 128 + n * 16)); }
        st1.run(acc, u, wr, wc, fr, fq, lds, wid, lane);
        f32x4 gv[2][2];
#pragma unroll
        for (int bj = 0; bj < 2; ++bj)
#pragma unroll
            for (int n = 0; n < 2; ++n) gv[bj][n] = *(const f32x4*)(g1 + col0 + bj * 128 + n * 16);
#pragma unroll
        for (int ai = 0; ai < 2; ++ai)
#pragma unroll
            for (int m = 0; m < 4; ++m) { const int r = ai * 128 + wr * 64 + m * 16 + fr; const float inv = S[r]; const size_t off = (size_t)(u.pm * 256 + r) * D + col0;
#pragma unroll
                for (int bj = 0; bj < 2; ++bj)
#pragma unroll
                    for (int n = 0; n < 2; ++n) { const f32x4 xv = (ai == 0) ? pre[m][bj][n] : __builtin_nontemporal_load((const f32x4*)(x + off + bj * 128 + n * 16)); acc[ai][bj][m][n] = xv + acc[ai][bj][m][n] * inv * gv[bj][n]; }
                asm volatile("" : "+v"(acc[ai][0][m][0]), "+v"(acc[ai][0][m][1]), "+v"(acc[ai][1][m][0]), "+v"(acc[ai][1][m][1]));
                if (m & 1) asm volatile("" ::: "memory"); }
        st2.run(acc, u, wr, wc, fr, fq, lds, wid, lane);
#pragma unroll
        for (int bj = 0; bj < 2; ++bj)
#pragma unroll
            for (int n = 0; n < 2; ++n) gv[bj][n] = *(const f32x4*)(g2 + col0 + bj * 128 + n * 16);
#pragma unroll
        for (int ai = 0; ai < 2; ++ai)
#pragma unroll
            for (int m = 0; m < 4; ++m) { const int r = ai * 128 + wr * 64 + m * 16 + fr; const float inv = S[r]; const size_t off = (size_t)(u.pm * 256 + r) * D + col0;
#pragma unroll
                for (int bj = 0; bj < 2; ++bj)
#pragma unroll
                    for (int n = 0; n < 2; ++n) { const f32x4 x1 = acc[ai][bj][m][n]; *(f32x4*)(out + off + bj * 128 + n * 16) = x1;
                        const f32x4 o = x1 * inv * gv[bj][n]; u32x2 w; w.x = cvt_pk_bf16(o[0], o[1]); w.y = cvt_pk_bf16(o[2], o[3]); *(u32x2*)(h2 + off + bj * 128 + n * 16) = w; }
                asm volatile("" ::: "memory"); }
    }
};
struct EpiNormB {
    static constexpr bool PERM = false, HALO = false, HAS_MID = false, AFTER_DRAIN = true;
    const float* base; float* out; const float* g; PanelSS st;
    __device__ __forceinline__ void mid(f32x4 (&)[2][2][4][2], const Unit&, int, int, int, int) const {}
    __device__ __forceinline__ void fused(f32x4 (&acc)[2][2][4][2], const Unit& u, int wr, int wc, int fr, int fq, LAS unsigned char* lds, int wid, int lane) const {
        const LAS float* S = (const LAS float*)(lds + 4096);
        const int col0 = u.pn * 256 + wc * 32 + 4 * fq;
        f32x4 pre[4][2][2];
#pragma unroll
        for (int m = 0; m < 4; ++m) { const size_t off = (size_t)(u.pm * 256 + wr * 64 + m * 16 + fr) * D + col0;
#pragma unroll
            for (int bj = 0; bj < 2; ++bj)
#pragma unroll
                for (int n = 0; n < 2; ++n) pre[m][bj][n] = __builtin_nontemporal_load((const f32x4*)(base + off + bj * 128 + n * 16)); }
        st.run(acc, u, wr, wc, fr, fq, lds, wid, lane);
        f32x4 gv[2][2];
#pragma unroll
        for (int bj = 0; bj < 2; ++bj)
#pragma unroll
            for (int n = 0; n < 2; ++n) gv[bj][n] = *(const f32x4*)(g + col0 + bj * 128 + n * 16);
#pragma unroll
        for (int ai = 0; ai < 2; ++ai)
#pragma unroll
            for (int m = 0; m < 4; ++m) { const int r = ai * 128 + wr * 64 + m * 16 + fr; const float inv = S[r]; const size_t off = (size_t)(u.pm * 256 + r) * D + col0;
#pragma unroll
                for (int bj = 0; bj < 2; ++bj)
#pragma unroll
                    for (int n = 0; n < 2; ++n) { const f32x4 bs = (ai == 0) ? pre[m][bj][n] : __builtin_nontemporal_load((const f32x4*)(base + off + bj * 128 + n * 16)); __builtin_nontemporal_store(bs + acc[ai][bj][m][n] * inv * gv[bj][n], (f32x4*)(out + off + bj * 128 + n * 16)); }
                if (m & 1) asm volatile("" ::: "memory"); }
    }
};
}

constexpr int A_BUF = 23552, A_KX = 9216, A_V = 11264, A_VP = 192;
constexpr float A_THR = 8.0f;
__device__ __forceinline__ int crow(int r, int hi) { return (r & 3) + 8 * (r >> 2) + 4 * hi; }
#define MFMA32(a, b, c) __builtin_amdgcn_mfma_f32_32x32x16_bf16((a), (b), (c), 0, 0, 0)
typedef short v4i16_t __attribute__((ext_vector_type(4)));
__device__ __forceinline__ v4i16_t vtr(LAS const unsigned char* p) { return __builtin_amdgcn_ds_read_tr16_b64_v4i16((LAS v4i16_t*)p); }
__device__ __forceinline__ float swap_max(float v) { auto rr = __builtin_amdgcn_permlane32_swap(__float_as_uint(v), __float_as_uint(v), false, false); return fmaxf(__uint_as_float(rr[0]), __uint_as_float(rr[1])); }
__device__ __forceinline__ float swap_sum(float v) { auto rr = __builtin_amdgcn_permlane32_swap(__float_as_uint(v), __float_as_uint(v), false, false); return __uint_as_float(rr[0]) + __uint_as_float(rr[1]); }

struct AttnAcc { f32x16 o0, o1, negm; float m, l; bool first; };
__device__ __forceinline__ void attn_init(AttnAcc& st) {
#pragma unroll
    for (int r = 0; r < 16; ++r) { st.o0[r] = 0.f; st.o1[r] = 0.f; st.negm[r] = 0.f; }
    st.m = 0.f; st.l = 0.f; st.first = true;
}

template <int MODE, bool BIAS>
__device__ __forceinline__ void attn_tile(AttnAcc& st, const bf16x8 (&qr)[4], const bf16x8 qx, LAS const unsigned char* Ks, LAS const unsigned char* Vs,
                                          int r32, int hi, int lane, int qidx, int k0, bool domask) {
    f32x16 p0, p1;
    LAS const unsigned char* kp = Ks + r32 * 144 + hi * 16;
    {
        const bf16x8 k0f = *(LAS const bf16x8*)(kp), k1f = *(LAS const bf16x8*)(kp + 32 * 144);
        p0 = MFMA32(k0f, qr[0], st.negm); p1 = MFMA32(k1f, qr[0], st.negm);
    }
#pragma unroll
    for (int d0 = 1; d0 < 4; ++d0) {
        const bf16x8 k0f = *(LAS const bf16x8*)(kp + d0 * 32), k1f = *(LAS const bf16x8*)(kp + 32 * 144 + d0 * 32);
        p0 = MFMA32(k0f, qr[d0], p0); p1 = MFMA32(k1f, qr[d0], p1);
    }
    if (BIAS) {
        LAS const unsigned char* xp = Ks + A_KX + r32 * 32 + hi * 16;
        const bf16x8 x0 = *(LAS const bf16x8*)(xp), x1 = *(LAS const bf16x8*)(xp + 32 * 32);
        p0 = MFMA32(x0, qx, p0); p1 = MFMA32(x1, qx, p1);
    }
    LAS const unsigned char* vp = Vs + (4 * hi + ((lane & 15) >> 2)) * A_VP + (16 * ((lane >> 4) & 1) + 4 * (lane & 3)) * 2;
    v4i16_t va0[4], va1[4], vb0[4], vb1[4];
#pragma unroll
    for (int c = 0; c < 4; ++c) { va0[c] = vtr(vp + (16 * c) * A_VP); va1[c] = vtr(vp + (16 * c + 8) * A_VP); vb0[c] = vtr(vp + (16 * c) * A_VP + 64); vb1[c] = vtr(vp + (16 * c + 8) * A_VP + 64); }
    if (MODE == 1) {
        if (domask)
#pragma unroll
        for (int r = 0; r < 16; ++r) { const int kv = k0 + crow(r, hi); if (kv > qidx) p0[r] = NEGBIG; if (kv + 32 > qidx) p1[r] = NEGBIG; }
    } else if (MODE == 2) {
#pragma unroll
        for (int r = 0; r < 16; ++r) { const int dist = qidx - (k0 + crow(r, hi)); if ((unsigned)dist > 128u) p0[r] = NEGBIG; if ((unsigned)(dist - 32) > 128u) p1[r] = NEGBIG; }
    }
    float rm = fmaxf(fmaxf(p0[0], p1[0]), fmaxf(p0[1], p1[1]));
#pragma unroll
    for (int r = 2; r < 16; r += 2) rm = fmaxf(fmaxf(rm, p0[r]), fmaxf(fmaxf(p1[r], p0[r + 1]), p1[r + 1]));
    rm = swap_max(rm);
    if (__any((int)(st.first || rm > A_THR))) {
        const float dl = st.first ? fmaxf(rm, -64.0f) : fmaxf(rm, 0.0f);
        st.m += dl;
#pragma unroll
        for (int r = 0; r < 16; ++r) { p0[r] -= dl; p1[r] -= dl; }
        const float nm = -st.m;
#pragma unroll
        for (int r = 0; r < 16; ++r) st.negm[r] = nm;
        const float f = __builtin_amdgcn_exp2f(-dl);
        st.l *= f;
#pragma unroll
        for (int r = 0; r < 16; ++r) { st.o0[r] *= f; st.o1[r] *= f; }
        st.first = false;
    }
    float ls = 0.f;
#pragma unroll
    for (int r = 0; r < 16; ++r) { p0[r] = __builtin_amdgcn_exp2f(p0[r]); p1[r] = __builtin_amdgcn_exp2f(p1[r]); ls += p0[r] + p1[r]; }
    st.l += ls;
#pragma unroll
    for (int c = 0; c < 4; ++c) {
        u32x4 pw;
        if (c == 0) { pw.x = cvt_pk_bf16(p0[0], p0[1]); pw.y = cvt_pk_bf16(p0[2], p0[3]); pw.z = cvt_pk_bf16(p0[4], p0[5]); pw.w = cvt_pk_bf16(p0[6], p0[7]); }
        else if (c == 1) { pw.x = cvt_pk_bf16(p0[8], p0[9]); pw.y = cvt_pk_bf16(p0[10], p0[11]); pw.z = cvt_pk_bf16(p0[12], p0[13]); pw.w = cvt_pk_bf16(p0[14], p0[15]); }
        else if (c == 2) { pw.x = cvt_pk_bf16(p1[0], p1[1]); pw.y = cvt_pk_bf16(p1[2], p1[3]); pw.z = cvt_pk_bf16(p1[4], p1[5]); pw.w = cvt_pk_bf16(p1[6], p1[7]); }
        else { pw.x = cvt_pk_bf16(p1[8], p1[9]); pw.y = cvt_pk_bf16(p1[10], p1[11]); pw.z = cvt_pk_bf16(p1[12], p1[13]); pw.w = cvt_pk_bf16(p1[14], p1[15]); }
        const bf16x8 pb = __builtin_bit_cast(bf16x8, pw);
        const v4i16_t a0 = va0[c], a1 = va1[c], b0 = vb0[c], b1 = vb1[c];
        const bf16x8 v0f = (bf16x8){a0[0], a0[1], a0[2], a0[3], a1[0], a1[1], a1[2], a1[3]};
        const bf16x8 v1f = (bf16x8){b0[0], b0[1], b0[2], b0[3], b1[0], b1[1], b1[2], b1[3]};
        st.o0 = MFMA32(v0f, pb, st.o0); st.o1 = MFMA32(v1f, pb, st.o1);
    }
}

#define ATT_STORE(buf) do { \
    *(LAS u32x4*)(lds + (buf) * A_BUF + srow * 144 + sch * 16) = kreg; \
    *(LAS u32x4*)(lds + (buf) * A_BUF + A_V + srow * A_VP + sch * 16) = vreg; } while (0)

__device__ __forceinline__ void attn_finish(AttnAcc& st, bf16* orow, int hi, float* lse_out) {
    const float l = swap_sum(st.l);
    const float inv = 1.0f / l;
#pragma unroll
    for (int g4 = 0; g4 < 4; ++g4) {
        u32x2 w0, w1;
        w0.x = cvt_pk_bf16(st.o0[4 * g4] * inv, st.o0[4 * g4 + 1] * inv); w0.y = cvt_pk_bf16(st.o0[4 * g4 + 2] * inv, st.o0[4 * g4 + 3] * inv);
        w1.x = cvt_pk_bf16(st.o1[4 * g4] * inv, st.o1[4 * g4 + 1] * inv); w1.y = cvt_pk_bf16(st.o1[4 * g4 + 2] * inv, st.o1[4 * g4 + 3] * inv);
        *(u32x2*)(orow + 8 * g4 + 4 * hi) = w0; *(u32x2*)(orow + 32 + 8 * g4 + 4 * hi) = w1;
    }
    if (lse_out && hi == 0) *lse_out = st.m + __builtin_amdgcn_logf(l);
}

__device__ __forceinline__ u32x4 bias_terms(float b) {
    const unsigned h = cvt_pk_bf16(b, 0.f) & 0xffffu; const float r1 = b - __uint_as_float(h << 16);
    const unsigned m = cvt_pk_bf16(r1, 0.f) & 0xffffu; const float r2 = r1 - __uint_as_float(m << 16);
    const unsigned l = cvt_pk_bf16(r2, 0.f) & 0xffffu;
    return (u32x4){h | (m << 16), l, 0u, 0u};
}

__device__ __forceinline__ void fox_unit(LAS unsigned char* lds, int b, int h, int qb, const bf16* QA, const bf16* KA, const bf16* VA, const float* Fall, bf16* O2, const unsigned* khp) {
    const int tid = threadIdx.x, lane = tid & 63, r32 = lane & 31, hi = lane >> 5, wid = __builtin_amdgcn_readfirstlane(tid >> 6);
    const int srow = tid >> 3, sch = tid & 7;
    const long rowbase = (long)b * SEQ; const int q0 = qb * 256;
    const float* Fh = Fall + (size_t)(b * NH + h) * SEQ;
    const float fref = Fh[q0];
    const bf16* Kh = KA + rowbase * 512 + h * 64 + 8 * sch; const bf16* Vh = VA + rowbase * 512 + h * 64 + 8 * sch;
    const int qidx = q0 + wid * 32 + r32;
    bf16x8 qr[4];
    { const bf16* qp = QA + (rowbase + qidx) * 512 + h * 64 + hi * 8;
#pragma unroll
      for (int d0 = 0; d0 < 4; ++d0) qr[d0] = *(const bf16x8*)(qp + d0 * 16); }
    const short one = (hi == 0) ? (short)0x3F80 : (short)0;
    const bf16x8 qx = (bf16x8){one, one, one, 0, 0, 0, 0, 0};
    AttnAcc st; attn_init(st);
    const int NT = 4 * (qb + 1);
    int t0 = 0;
    {
        float qq = 0.f;
#pragma unroll
        for (int d0 = 0; d0 < 4; ++d0)
#pragma unroll
            for (int e = 0; e < 8; ++e) { const float f = __uint_as_float(((unsigned)(unsigned short)qr[d0][e]) << 16); qq += f * f; }
        qq = swap_sum(qq);
        qq = fmaxf(qq, __shfl_xor(qq, 1)); qq = fmaxf(qq, __shfl_xor(qq, 2)); qq = fmaxf(qq, __shfl_xor(qq, 4)); qq = fmaxf(qq, __shfl_xor(qq, 8)); qq = fmaxf(qq, __shfl_xor(qq, 16));
        LAS float* ctl = (LAS float*)(lds + 48000);
        if (lane == 0) ctl[wid] = qq;
        __syncthreads();
        float q2 = ctl[0];
#pragma unroll
        for (int w = 1; w < 8; ++w) q2 = fmaxf(q2, ctl[w]);
        const float k2 = __uint_as_float(khp[(b * NH + h) * 2]) + __uint_as_float(khp[(b * NH + h) * 2 + 1]);
        const float thr = 150.0f + 2.04f * sqrtf(q2 * k2);
        const bool skip = (lane < 4 * qb) && ((fref - Fh[64 * lane + 63]) * LOG2E < -thr);
        t0 = __popcll(__ballot(skip));
    }
    u32x4 kreg, vreg; float breg = 0.f;
    { const size_t ro = (size_t)(64 * (NT - 1) + srow) * 512; kreg = *(const u32x4*)(Kh + ro); vreg = *(const u32x4*)(Vh + ro); if (tid < 64) breg = (fref - Fh[64 * (NT - 1) + tid]) * LOG2E; }
    const int qmin = q0 + wid * 32, qmax = qmin + 31;
    for (int t = NT - 1; t >= t0; --t) {
        const int buf = t & 1;
        ATT_STORE(buf);
        if (tid < 64) { LAS u32x4* xp = (LAS u32x4*)(lds + buf * A_BUF + A_KX + tid * 32); xp[0] = bias_terms(breg); xp[1] = (u32x4){0u, 0u, 0u, 0u}; }
        __syncthreads();
        if (t > t0) { const size_t ro = (size_t)(64 * (t - 1) + srow) * 512; kreg = *(const u32x4*)(Kh + ro); vreg = *(const u32x4*)(Vh + ro); if (tid < 64) breg = (fref - Fh[64 * (t - 1) + tid]) * LOG2E; }
        const int k0 = 64 * t;
        if (k0 <= qmax) {
            LAS const unsigned char* Ks = lds + buf * A_BUF; LAS const unsigned char* Vs = lds + buf * A_BUF + A_V;
            attn_tile<1, true>(st, qr, qx, Ks, Vs, r32, hi, lane, qidx, k0, k0 + 63 > qmin);
        }
    }
    attn_finish(st, O2 + (rowbase + qidx) * 1024 + h * 64, hi, nullptr);
    __syncthreads();
}

constexpr int DL_V = 384 * 144;
struct DilU { int g, b, h, r, u, d; };
__device__ __forceinline__ DilU dil_decode(int id) {
    DilU U; U.g = id / 512; const int rest = id % 512, bh = rest >> 4, idx = rest & 15; U.b = bh >> 3; U.h = bh & 7;
    if (U.g == 0) { U.r = 0; U.u = idx; U.d = 1; } else if (U.g == 1) { U.r = idx & 3; U.u = idx >> 2; U.d = 4; } else { U.r = idx; U.u = 0; U.d = 16; }
    return U;
}
__device__ __forceinline__ void dil_phase(LAS unsigned char* lds, int bx, int G, const bf16* QB, const bf16* KB, const bf16* VB, bf16* OD, float* LSE) {
    const int tid = threadIdx.x, lane = tid & 63, r32 = lane & 31, hi = lane >> 5, wid = __builtin_amdgcn_readfirstlane(tid >> 6);
    const int srow = tid >> 3, sch = tid & 7;
    constexpr int NU = 3 * 32 * 16;
    if (bx >= NU) return;
    u32x4 kreg[6], vreg[6]; bf16x8 qn[4];
#define DIL_LOAD(U) do { const long rb_ = (long)(U).b * SEQ; const int kb_ = 256 * (U).u - 128, j0_ = ((U).u == 0) ? 2 : 0; \
        _Pragma("unroll") for (int j = 0; j < 6; ++j) { if (j >= j0_) { const size_t ro_ = (size_t)(rb_ + (long)(kb_ + 64 * j + srow) * (U).d + (U).r) * 512 + (U).h * 64 + 8 * sch; \
            kreg[j] = *(const u32x4*)(KB + ro_); vreg[j] = *(const u32x4*)(VB + ro_); } } \
        const bf16* qp_ = QB + (size_t)(rb_ + (long)(256 * (U).u + wid * 32 + r32) * (U).d + (U).r) * 512 + (U).h * 64 + hi * 8; \
        _Pragma("unroll") for (int d0 = 0; d0 < 4; ++d0) qn[d0] = *(const bf16x8*)(qp_ + d0 * 16); } while (0)
    DilU U = dil_decode(bx);
    DIL_LOAD(U);
    const bf16x8 qx = (bf16x8){0, 0, 0, 0, 0, 0, 0, 0};
    for (int id = bx; id < NU; id += G) {
        const int j0 = (U.u == 0) ? 2 : 0;
#pragma unroll
        for (int j = 0; j < 6; ++j) { if (j >= j0) { *(LAS u32x4*)(lds + (64 * j + srow) * 144 + sch * 16) = kreg[j]; *(LAS u32x4*)(lds + DL_V + (64 * j + srow) * A_VP + sch * 16) = vreg[j]; } }
        bf16x8 qr[4];
#pragma unroll
        for (int d0 = 0; d0 < 4; ++d0) qr[d0] = qn[d0];
        __syncthreads();
        const DilU C = U;
        if (id + G < NU) { U = dil_decode(id + G); DIL_LOAD(U); }
        AttnAcc st; attn_init(st);
        const int kbase = 256 * C.u - 128, qlo = 256 * C.u + wid * 32, qs = qlo + r32;
#pragma unroll 1
        for (int j = j0; j < 6; ++j) {
            const int k0 = kbase + 64 * j;
            if (k0 + 63 >= qlo - 128 && k0 <= qlo + 31)
                attn_tile<2, false>(st, qr, qx, lds + j * (64 * 144), lds + DL_V + j * (64 * A_VP), r32, hi, lane, qs, k0, true);
        }
        const long qrow = (long)C.b * SEQ + (long)qs * C.d + C.r;
        attn_finish(st, OD + ((size_t)C.g * T + qrow) * 512 + C.h * 64, hi, LSE + ((size_t)C.g * T + qrow) * NH + C.h);
        __syncthreads();
    }
#undef DIL_LOAD
}

#define XB_TMO      128
#define XB_XCNT(j)  (256  + 64 * (j))
#define XB_XSUB(j)  (1280 + 64 * (j))
#define XB_XGEN(j)  (2304 + 64 * (j))
#define XB_TOP      3328
#define XB_TOPGEN   3392
#define XCD_BAR_WORDS 3456
#define XB_SPIN_CAP (1u << 22)
__device__ __forceinline__ unsigned xb_ld(unsigned* p)              { return __hip_atomic_load(p, __ATOMIC_RELAXED, __HIP_MEMORY_SCOPE_AGENT); }
__device__ __forceinline__ unsigned xb_add(unsigned* p, unsigned v) { return __hip_atomic_fetch_add(p, v, __ATOMIC_RELAXED, __HIP_MEMORY_SCOPE_AGENT); }
__device__ __forceinline__ unsigned xb_xcc_id() { return (unsigned)__builtin_amdgcn_s_getreg((3 << 11) | 20) & 0xFu; }
#define XB_SPIN(cond, bar) do { unsigned _sp = 0; while (cond) { __builtin_amdgcn_s_sleep(1); \
    if ((++_sp & 255u) == 0u) { if (xb_ld(&(bar)[XB_TMO])) break; if (_sp > XB_SPIN_CAP) { atomicAdd(&(bar)[XB_TMO], 1u); break; } } } } while (0)
struct XcdBarrier { unsigned* bar; unsigned x; volatile LAS unsigned* st; };
__device__ __forceinline__ XcdBarrier xcd_barrier_post(unsigned* bar, volatile LAS unsigned* st) {
    XcdBarrier b; b.bar = bar; b.x = xb_xcc_id(); b.st = st;
    if (threadIdx.x == 0) (void)xb_add(&bar[XB_XCNT(b.x)], 1u);
    return b;
}
__device__ __forceinline__ void xcd_barrier_complete(unsigned* bar, unsigned x, unsigned& nloc, unsigned& nx) {
    const unsigned G = gridDim.x * gridDim.y * gridDim.z;
    unsigned sum, cnt, mine, sp = 0u;
    for (;;) {
        sum = 0u; cnt = 0u; mine = 0u;
#pragma unroll
        for (unsigned j = 0; j < 16; ++j) { const unsigned c = xb_ld(&bar[XB_XCNT(j)]); sum += c; cnt += (c > 0u) ? 1u : 0u; mine = (j == x) ? c : mine; }
        if (sum == G) break;
        __builtin_amdgcn_s_sleep(1);
        if ((++sp & 255u) == 0u) { if (xb_ld(&bar[XB_TMO])) break; if (sp > XB_SPIN_CAP) { atomicAdd(&bar[XB_TMO], 1u); break; } }
    }
    nloc = mine > 0u ? mine : 1u; nx = cnt > 0u ? cnt : 1u;
}
__device__ __forceinline__ void xcd_barrier(const XcdBarrier& b) {
    asm volatile("s_waitcnt vmcnt(0)" ::: "memory");
    __syncthreads();
    if (threadIdx.x == 0) {
        unsigned* bar = b.bar;
        __builtin_amdgcn_s_waitcnt(0);
        unsigned nloc = b.st[0], nx = b.st[1];
        if (nloc == 0u) { xcd_barrier_complete(bar, b.x, nloc, nx); b.st[0] = nloc; b.st[1] = nx; }
        const unsigned old = xb_add(&bar[XB_XSUB(b.x)], 1u);
        const unsigned gen = old / nloc;
        if (old + 1u == (gen + 1u) * nloc) {
            __builtin_amdgcn_fence(__ATOMIC_RELEASE, "agent");
            asm volatile("s_waitcnt vmcnt(0)" ::: "memory");
            const unsigned og = xb_add(&bar[XB_TOP], 1u);
            const unsigned tg = og / nx;
            if (og + 1u == (tg + 1u) * nx) xb_add(&bar[XB_TOPGEN], 1u);
            else XB_SPIN(xb_ld(&bar[XB_TOPGEN]) == tg, bar);
            __builtin_amdgcn_fence(__ATOMIC_ACQUIRE, "agent");
            xb_add(&bar[XB_XGEN(b.x)], 1u);
            asm volatile("s_waitcnt vmcnt(0)" ::: "memory");
        } else {
            XB_SPIN(xb_ld(&bar[XB_XGEN(b.x)]) == gen, bar);
            __builtin_amdgcn_fence(__ATOMIC_ACQUIRE, "agent");
            asm volatile("s_waitcnt vmcnt(0)" ::: "memory");
        }
    }
    __syncthreads();
}

struct Args {
    const float* in[14]; float* out; unsigned char* ws; double invf[8]; int ph_lo, ph_hi; int coop, li;
};

__device__ __forceinline__ void p0_transpose_item(const float* W, int ldw, int k0, int c0, bf16* WT, int ldt, int drow0, int dk0, LAS float* scr, int lane) {
    float tmp[32];
#pragma unroll
    for (int i = 0; i < 32; ++i) { const int kk = 2 * i + (lane >> 5); tmp[i] = __builtin_nontemporal_load(&W[(size_t)(k0 + kk) * ldw + c0 + (lane & 31)]); }
#pragma unroll
    for (int i = 0; i < 32; ++i) { const int kk = 2 * i + (lane >> 5); scr[kk * 33 + (lane & 31)] = tmp[i]; }
    asm volatile("s_waitcnt lgkmcnt(0)" ::: "memory");
    const int c = lane & 7;
#pragma unroll
    for (int j = 0; j < 4; ++j) { const int n = (lane >> 3) + 8 * j; const LAS float* s = scr + (8 * c) * 33 + n;
        u32x4 o; o.x = cvt_pk_bf16(s[0 * 33], s[1 * 33]); o.y = cvt_pk_bf16(s[2 * 33], s[3 * 33]); o.z = cvt_pk_bf16(s[4 * 33], s[5 * 33]); o.w = cvt_pk_bf16(s[6 * 33], s[7 * 33]);
        *(u32x4*)(WT + (size_t)(drow0 + n) * ldt + dk0 + 8 * c) = o; }
    asm volatile("s_waitcnt lgkmcnt(0)" ::: "memory");
}

__global__ void __launch_bounds__(NTHR, 2) mega_fwd(Args args) {
    extern __shared__ __attribute__((aligned(16))) unsigned char lds_raw[];
    LAS unsigned char* lds = (LAS unsigned char*)lds_raw;
    const int tid = threadIdx.x, lane = tid & 63, wave = __builtin_amdgcn_readfirstlane(tid >> 6);
    const int G = gridDim.x, bx = blockIdx.x;
    const int gw = bx * NWAVES + wave, NGW = G * NWAVES;
    unsigned char* ws = args.ws;
    const float* x = args.in[0]; const float* g_pre_mix = args.in[1]; const float* w_in = args.in[2]; const float* b_forget = args.in[3];
    const float* w_o_fox = args.in[4]; const float* w_o_dil = args.in[5]; const float* w_out = args.in[6]; const float* g_post_mix = args.in[7];
    const float* g_pre_ffn = args.in[8]; const float* w_up = args.in[9]; const float* conv_w = args.in[10]; const float* conv_b = args.in[11];
    const float* w_down = args.in[12]; const float* g_post_ffn = args.in[13];
    float* out = args.out;
    float* cosT = (float*)(ws + WS_COS); float* sinT = (float*)(ws + WS_SIN); float* LOGF = (float*)(ws + WS_LOGF); float* Fc = (float*)(ws + WS_F); float* LSE = (float*)(ws + WS_LSE);
    bf16* WIN_T = (bf16*)(ws + WS_WIN); bf16* WO_T = (bf16*)(ws + WS_WO); bf16* WOUT_T = (bf16*)(ws + WS_WOUT); bf16* WUP_T = (bf16*)(ws + WS_WUP); bf16* WDN_T = (bf16*)(ws + WS_WDN);
    bf16* QKV = (bf16*)(ws + WS_QKV); bf16* SGA = (bf16*)(ws + WS_SGA); bf16* SGB = (bf16*)(ws + WS_SGB); bf16* Hn = (bf16*)(ws + WS_H);
    bf16* OD = (bf16*)(ws + WS_OD); bf16* O2 = (bf16*)((unsigned char*)out + 32 * MiB);    bf16* H2 = (bf16*)(ws + WS_H2); bf16* MF = (bf16*)(ws + WS_M);
    bf16* MIXED = (bf16*)(ws + WS_MIXED);
    const int lo = args.ph_lo, hi_ph = args.ph_hi;
#define IN(k) (lo <= (k) && (k) < hi_ph)
    ((volatile LAS unsigned*)(lds + RING_BYTES))[tid & 63] = 0u;
    __syncthreads();
    XcdBarrier xbar; xbar.bar = (unsigned*)(ws + WS_BAR) + args.li * XCD_BAR_WORDS; xbar.x = 0; xbar.st = nullptr;
    if (args.coop == 1) xbar = xcd_barrier_post((unsigned*)(ws + WS_BAR) + args.li * XCD_BAR_WORDS, (volatile LAS unsigned*)(lds + RING_BYTES));
#define SEAM(k) do { if (IN(k) && IN((k) + 1)) { if (args.coop == 2) { __threadfence(); cg::this_grid().sync(); } else xcd_barrier(xbar); } } while (0)

    if (IN(0)) {
        LAS float* scr = (LAS float*)(lds + wave * 9216);
        LAS float* wfl = (LAS float*)(lds + 73728);
        for (int k = tid; k < D; k += NTHR) {
#pragma unroll
            for (int j = 0; j < 8; ++j) wfl[j * 1024 + k] = w_in[(size_t)k * INW + 1536 + j];
        }
        constexpr int I_IN = 16 * 160, I_OA = 8 * 32, I_OUT = 16 * 32, I_UP = 16 * 176, I_DN = 44 * 32;
        constexpr int NITEMS = I_IN + 2 * I_OA + I_OUT + I_UP + I_DN;
        for (int it = gw; it < I_IN; it += NGW) {
            int r = it;
            if (r < I_IN) { const int kb = r / 160, nb = r % 160, n0 = 32 * nb; p0_transpose_item(w_in, INW, 64 * kb, n0 + (n0 >= 1536 ? 8 : 0), WIN_T, D, n0, 64 * kb, scr, lane); continue; } r -= I_IN;
            if (r < I_OA) { const int kb = r / 32, nb = r % 32; p0_transpose_item(w_o_fox, D, 64 * kb, 32 * nb, WO_T, D, 32 * nb, 64 * kb, scr, lane); continue; } r -= I_OA;
            if (r < I_OA) { const int kb = r / 32, nb = r % 32; p0_transpose_item(w_o_dil, D, 64 * kb, 32 * nb, WO_T, D, 32 * nb, 512 + 64 * kb, scr, lane); continue; } r -= I_OA;
            if (r < I_OUT) { const int kb = r / 32, nb = r % 32; p0_transpose_item(w_out, D, 64 * kb, 32 * nb, WOUT_T, D, 32 * nb, 64 * kb, scr, lane); continue; } r -= I_OUT;
            if (r < I_UP) { const int kb = r / 176, nb = r % 176, n0 = 32 * nb, pn = n0 >> 8, i = n0 & 255; const int c0 = (i < 128) ? (128 * pn + i) : (FF + 128 * pn + i - 128);
                p0_transpose_item(w_up, NUP, 64 * kb, c0, WUP_T, D, n0, 64 * kb, scr, lane); continue; } r -= I_UP;
            { const int kb = r / 32, nb = r % 32; p0_transpose_item(w_down, D, 64 * kb, 32 * nb, WDN_T, FF, 32 * nb, 64 * kb, scr, lane); }
        }
        for (int id = bx * NTHR + tid; id < SEQ * 8; id += G * NTHR) {
            const int pos = id >> 3, i = id & 7;
            const double ang = (double)pos * args.invf[i];
            const double TWO_PI = 6.283185307179586476925286766559;
            const double kq = __builtin_rint(ang / TWO_PI);
            const double rr = (ang - kq * TWO_PI) * 0.25;
            const double r2 = rr * rr;
            double sn = rr * (1.0 + r2 * (-1.0 / 6 + r2 * (1.0 / 120 + r2 * (-1.0 / 5040 + r2 * (1.0 / 362880 + r2 * (-1.0 / 39916800 + r2 * (1.0 / 6227020800.0 + r2 * (-1.0 / 1307674368000.0))))))));
            double cs = 1.0 + r2 * (-0.5 + r2 * (1.0 / 24 + r2 * (-1.0 / 720 + r2 * (1.0 / 40320 + r2 * (-1.0 / 3628800 + r2 * (1.0 / 479001600 + r2 * (-1.0 / 87178291200.0 + r2 * (1.0 / 20922789888000.0))))))));
#pragma unroll
            for (int k2 = 0; k2 < 2; ++k2) { const double s2 = 2.0 * sn * cs, c2 = cs * cs - sn * sn; sn = s2; cs = c2; }
            cosT[id] = (float)cs; sinT[id] = (float)sn;
        }
        __syncthreads();
        {
            f32x4 wreg[8][4];
#pragma unroll
            for (int q = 0; q < 8; ++q)
#pragma unroll
                for (int j = 0; j < 4; ++j) wreg[q][j] = *((LAS const f32x4*)(wfl + q * 1024) + lane + 64 * j);
            f32x4 gg[4];
#pragma unroll
            for (int j = 0; j < 4; ++j) gg[j] = *((const f32x4*)g_pre_mix + lane + 64 * j);
            const float bfv = (lane < 8) ? b_forget[lane] : 0.f;
            f32x4 vn[4];
            if (gw < T) {
#pragma unroll
                for (int j = 0; j < 4; ++j) vn[j] = __builtin_nontemporal_load((const f32x4*)(x + (size_t)gw * D) + lane + 64 * j);
            }
            for (int m = gw; m < T; m += NGW) {
                f32x4 v[4]; float s = 0.f;
#pragma unroll
                for (int j = 0; j < 4; ++j) { v[j] = vn[j]; s += (v[j].x * v[j].x + v[j].y * v[j].y) + (v[j].z * v[j].z + v[j].w * v[j].w); }
                if (m + NGW < T) {
#pragma unroll
                    for (int j = 0; j < 4; ++j) vn[j] = __builtin_nontemporal_load((const f32x4*)(x + (size_t)(m + NGW) * D) + lane + 64 * j);
                }
                const float inv = 1.0f / sqrtf(wave_sum(s) * (1.0f / D) + RMS_EPS);
                float dot[8];
#pragma unroll
                for (int q = 0; q < 8; ++q) dot[q] = 0.f;
                unsigned long long* o8 = (unsigned long long*)(Hn + (size_t)m * D) + lane;
#pragma unroll
                for (int j = 0; j < 4; ++j) {
                    const f32x4 hv = v[j] * inv * gg[j];
                    o8[64 * j] = (unsigned long long)cvt_pk_bf16(hv.x, hv.y) | ((unsigned long long)cvt_pk_bf16(hv.z, hv.w) << 32);
#pragma unroll
                    for (int q = 0; q < 8; ++q) { const f32x4 wv = wreg[q][j]; dot[q] += (hv.x * wv.x + hv.y * wv.y) + (hv.z * wv.z + hv.w * wv.w); }
                }
#pragma unroll
                for (int q = 0; q < 8; ++q) dot[q] = wave_sum(dot[q]);
                float z = dot[0];
#pragma unroll
                for (int q = 1; q < 8; ++q) z = (lane == q) ? dot[q] : z;
                if (lane < 8) { z += bfv;
                    const float e = __expf(-fabsf(z)); LOGF[(size_t)m * 8 + lane] = fminf(z, 0.f) - log1pf(e); }
            }
        }
    }
    SEAM(0);

    if (IN(1)) {
        for (int bh = bx; bh < NB * NH; bh += G) {
            const int bb = bh >> 3, hh = bh & 7;
            const float* src = LOGF + ((size_t)bb * SEQ + 8 * tid) * 8 + hh;
            float v[8]; float sloc = 0.f;
#pragma unroll
            for (int i = 0; i < 8; ++i) { sloc += src[i * 8]; v[i] = sloc; }
            float incl = sloc;
#pragma unroll
            for (int o = 1; o < 64; o <<= 1) { const float t = __shfl_up(incl, o); if (lane >= o) incl += t; }
            LAS float* wt = (LAS float*)lds;
            if (lane == 63) wt[wave] = incl;
            __syncthreads();
            float off = 0.f;
            for (int w = 0; w < wave; ++w) off += wt[w];
            const float base = off + incl - sloc;
            float* dst = Fc + (size_t)bh * SEQ + 8 * tid;
            *(f32x4*)dst = (f32x4){base + v[0], base + v[1], base + v[2], base + v[3]};
            *(f32x4*)(dst + 4) = (f32x4){base + v[4], base + v[5], base + v[6], base + v[7]};
            __syncthreads();
        }
        pg8::Gemm g{Hn, WIN_T, D}; pg8::StaticOrder S; S.init(T / 256, NZ / 256, G, bx);
        pg8::EpiZ E{QKV, SGA, SGB, cosT, sinT, (unsigned*)(ws + WS_KH)};
        pg8::gemm_phase<pg8::EpiZ, pg8::StaticOrder>(lds, g, S, E);
    }
    SEAM(1);

    if (IN(2)) {
        const bf16* QBp = QKV + (size_t)3 * T * 512; const bf16* KBp = QKV + (size_t)4 * T * 512; const bf16* VBp = QKV + (size_t)5 * T * 512;
        dil_phase(lds, (G % 8 == 0) ? (bx & 7) * (G >> 3) + (bx >> 3) : bx, G, QBp, KBp, VBp, OD, LSE);
        const bf16* QAp = QKV; const bf16* KAp = QKV + (size_t)T * 512; const bf16* VAp = QKV + (size_t)2 * T * 512;
        { unsigned* qhead = (unsigned*)(ws + WS_FQ) + args.li; LAS int* qid = (LAS int*)(lds + 48128);
          for (;;) {
              if (tid == 0) qid[0] = (int)atomicAdd(qhead, 1u);
              __syncthreads();
              const int id = qid[0];
              if (id >= 512) break;
              const int bh = id & 31;
              fox_unit(lds, bh >> 3, bh & 7, 15 - (id >> 5), QAp, KAp, VAp, Fc, O2, (const unsigned*)(ws + WS_KH));
          }
        }
        {
            constexpr int I_OA = 8 * 32, I_OUT = 16 * 32, I_UP = 16 * 176, I_DN = 44 * 32;
            constexpr int NREST = 2 * I_OA + I_OUT + I_UP + I_DN;
            __syncthreads();
            LAS float* scr = (LAS float*)(lds + wave * 9216);
            unsigned* whead = (unsigned*)(ws + WS_FQ) + 32 + args.li; LAS int* wq = (LAS int*)(lds + 8 * 9216);
            for (;;) {
                if (tid == 0) wq[0] = (int)atomicAdd(whead, 1u);
                __syncthreads();
                const int it = wq[0] * 8 + wave;
                __syncthreads();
                if (it - wave >= NREST) break;
                if (it >= NREST) continue;
                int r = it;
                if (r < I_OA) { const int kb = r / 32, nb = r % 32; p0_transpose_item(w_o_fox, D, 64 * kb, 32 * nb, WO_T, D, 32 * nb, 64 * kb, scr, lane); continue; } r -= I_OA;
                if (r < I_OA) { const int kb = r / 32, nb = r % 32; p0_transpose_item(w_o_dil, D, 64 * kb, 32 * nb, WO_T, D, 32 * nb, 512 + 64 * kb, scr, lane); continue; } r -= I_OA;
                if (r < I_OUT) { const int kb = r / 32, nb = r % 32; p0_transpose_item(w_out, D, 64 * kb, 32 * nb, WOUT_T, D, 32 * nb, 64 * kb, scr, lane); continue; } r -= I_OUT;
                if (r < I_UP) { const int kb = r / 176, nb = r % 176, n0 = 32 * nb, pn = n0 >> 8, i = n0 & 255; const int c0 = (i < 128) ? (128 * pn + i) : (FF + 128 * pn + i - 128);
                    p0_transpose_item(w_up, NUP, 64 * kb, c0, WUP_T, D, n0, 64 * kb, scr, lane); continue; } r -= I_UP;
                { const int kb = r / 32, nb = r % 32; p0_transpose_item(w_down, D, 64 * kb, 32 * nb, WDN_T, FF, 32 * nb, 64 * kb, scr, lane); }
            }
        }
    }
    SEAM(2);

    if (IN(3)) {
        pg8::StaticOrder S; S.init(T / 256, D / 256, G, bx);
        { pg8::Unit mu;
          if (S.next(0, mu)) {
            unsigned* pcnt = (unsigned*)(ws + WS_MC) + 32 * mu.pm;
            const size_t rbase = (size_t)mu.pm * 256 + 64 * mu.pn;
            for (int it0 = tid; it0 < 64 * 64; it0 += 4 * NTHR) {
                float l0[4], l1[4], l2[4]; u32x4 a[4], b[4], cc[4];
#pragma unroll
                for (int q = 0; q < 4; ++q) { const int it = it0 + q * NTHR; const size_t row = rbase + (it >> 6); const int hh = (it >> 3) & 7, c = it & 7;
                    l0[q] = LSE[row * NH + hh]; l1[q] = LSE[((size_t)T + row) * NH + hh]; l2[q] = LSE[((size_t)2 * T + row) * NH + hh];
                    const size_t off = row * 512 + hh * 64 + c * 8;
                    a[q] = __builtin_nontemporal_load((const u32x4*)(OD + off)); b[q] = __builtin_nontemporal_load((const u32x4*)(OD + (size_t)T * 512 + off)); cc[q] = __builtin_nontemporal_load((const u32x4*)(OD + (size_t)2 * T * 512 + off)); }
#pragma unroll
                for (int q = 0; q < 4; ++q) { const int it = it0 + q * NTHR; const size_t row = rbase + (it >> 6); const int hh = (it >> 3) & 7, c = it & 7;
                    const float mx = fmaxf(l0[q], fmaxf(l1[q], l2[q]));
                    float w0 = __builtin_amdgcn_exp2f(l0[q] - mx), w1 = __builtin_amdgcn_exp2f(l1[q] - mx), w2 = __builtin_amdgcn_exp2f(l2[q] - mx);
                    const float inv = 1.0f / (w0 + w1 + w2); w0 *= inv; w1 *= inv; w2 *= inv;
                    u32x4 o;
                    o.x = cvt_pk_bf16(w0 * bf_lo(a[q].x) + w1 * bf_lo(b[q].x) + w2 * bf_lo(cc[q].x), w0 * bf_hi(a[q].x) + w1 * bf_hi(b[q].x) + w2 * bf_hi(cc[q].x));
                    o.y = cvt_pk_bf16(w0 * bf_lo(a[q].y) + w1 * bf_lo(b[q].y) + w2 * bf_lo(cc[q].y), w0 * bf_hi(a[q].y) + w1 * bf_hi(b[q].y) + w2 * bf_hi(cc[q].y));
                    o.z = cvt_pk_bf16(w0 * bf_lo(a[q].z) + w1 * bf_lo(b[q].z) + w2 * bf_lo(cc[q].z), w0 * bf_hi(a[q].z) + w1 * bf_hi(b[q].z) + w2 * bf_hi(cc[q].z));
                    o.w = cvt_pk_bf16(w0 * bf_lo(a[q].w) + w1 * bf_lo(b[q].w) + w2 * bf_lo(cc[q].w), w0 * bf_hi(a[q].w) + w1 * bf_hi(b[q].w) + w2 * bf_hi(cc[q].w));
                    st_wt16(O2 + row * 1024 + 512 + hh * 64 + c * 8, o); }
            }
            asm volatile("s_waitcnt vmcnt(0)" ::: "memory");
            __syncthreads();
            if (tid == 0) {
                __hip_atomic_fetch_add(pcnt, 1u, __ATOMIC_RELAXED, __HIP_MEMORY_SCOPE_AGENT);
                unsigned sp = 0;
                while (__hip_atomic_load(pcnt, __ATOMIC_RELAXED, __HIP_MEMORY_SCOPE_AGENT) < 4u) { __builtin_amdgcn_s_sleep(2); if (++sp > (1u << 22)) break; }
                __builtin_amdgcn_fence(__ATOMIC_ACQUIRE, "agent");
                asm volatile("s_waitcnt vmcnt(0)" ::: "memory");
            }
            __syncthreads();
          }
        }
        pg8::Gemm g{O2, WO_T, D};
        pg8::EpiMix E{SGA, SGB, MIXED};
        pg8::gemm_phase<pg8::EpiMix, pg8::StaticOrder>(lds, g, S, E);
    }
    SEAM(3);

    if (IN(4)) {
        pg8::Gemm g{MIXED, WOUT_T, D}; pg8::StaticOrder S; S.init(T / 256, D / 256, G, bx);
        pg8::PanelSS st1{(unsigned*)(ws + WS_XBUF), (unsigned*)(ws + WS_CNT)};
        pg8::PanelSS st2{(unsigned*)(ws + WS_XBUF + 0x40000), (unsigned*)(ws + WS_CNT + 0x4000)};
        pg8::EpiNormA E{x, out, H2, g_post_mix, g_pre_ffn, st1, st2};
        pg8::gemm_phase<pg8::EpiNormA, pg8::StaticOrder>(lds, g, S, E);
    }
    SEAM(4);

    if (IN(5)) {
        pg8::Gemm g{H2, WUP_T, D}; pg8::StaticOrder S; S.init(67, NUP / 256, G, bx);
        pg8::EpiConvGelu E{conv_w, conv_b, MF};
        pg8::gemm_phase<pg8::EpiConvGelu, pg8::StaticOrder>(lds, g, S, E);
    }
    SEAM(5);

    if (IN(6)) {
        pg8::Gemm g{MF, WDN_T, FF}; pg8::StaticOrder S; S.init(T / 256, D / 256, G, bx);
        pg8::PanelSS st{(unsigned*)(ws + WS_XBUF + 0x80000), (unsigned*)(ws + WS_CNT + 0x8000)};
        pg8::EpiNormB E{out, out, g_post_ffn, st};
        pg8::gemm_phase<pg8::EpiNormB, pg8::StaticOrder>(lds, g, S, E);
    }
#undef IN
#undef SEAM
}

#ifndef MK_N_LAUNCHES
#define MK_N_LAUNCHES 1
#endif
constexpr int NPHASES = 7;

extern "C" void kernel_launch(void* const* d_in, const int* in_sizes, int n_in, void* d_out, int out_size, void* d_ws, size_t ws_size, hipStream_t stream) {
    static int grid = 0;
    if (grid == 0) {
        if (n_in != 14 || in_sizes[0] != T * D || out_size != T * D || ws_size < WS_NEED) {
            fprintf(stderr, "kernel_launch: unexpected shapes: n_in %d in0 %d out %d ws %zu\n", n_in, n_in > 0 ? in_sizes[0] : -1, out_size, ws_size); grid = -1; return; }
        int dev = 0, cus = 0, per_cu = 0;
        if (hipGetDevice(&dev) != hipSuccess || hipDeviceGetAttribute(&cus, hipDeviceAttributeMultiprocessorCount, dev) != hipSuccess) { fprintf(stderr, "kernel_launch: device query failed\n"); grid = -1; return; }
        if (hipFuncSetAttribute((const void*)mega_fwd, hipFuncAttributeMaxDynamicSharedMemorySize, LDS_BYTES) != hipSuccess) { fprintf(stderr, "kernel_launch: hipFuncSetAttribute failed\n"); grid = -1; return; }
        if (hipOccupancyMaxActiveBlocksPerMultiprocessor(&per_cu, (const void*)mega_fwd, NTHR, LDS_BYTES) != hipSuccess || per_cu < 1) { fprintf(stderr, "kernel_launch: occupancy query says %d\n", per_cu); per_cu = 1; }
        (void)hipGetLastError();
        grid = cus * per_cu;
        if (grid > 256) grid = 256;
        if (grid != 256) fprintf(stderr, "kernel_launch: grid %d != 256: the fused RMSNorm epilogues need 256 co-resident workgroups\n", grid);
        fprintf(stderr, "kernel_launch: grid %d (cus %d x %d)\n", grid, cus, per_cu);
    }
    if (grid < 0) return;
    if (hipMemsetAsync(d_ws, 0, WS_BAR_BYTES, stream) != hipSuccess) { fprintf(stderr, "kernel_launch: memset failed\n"); return; }
    Args a{};
    for (int i = 0; i < 14; ++i) a.in[i] = (const float*)d_in[i];
    a.out = (float*)d_out; a.ws = (unsigned char*)d_ws;
    for (int i = 0; i < 8; ++i) a.invf[i] = pow(500000.0, -(double)i / 8.0);
    a.li = 0;
#if defined(PROBE_SPLIT)
    { void* params[] = {&a}; a.coop = 1;
      a.ph_lo = 0; a.ph_hi = PROBE_SPLIT + 1; hipLaunchCooperativeKernel((const void*)mega_fwd, dim3(grid), dim3(NTHR), params, LDS_BYTES, stream);
      a.li = 1; a.ph_lo = PROBE_SPLIT + 1; a.ph_hi = NPHASES; hipLaunchCooperativeKernel((const void*)mega_fwd, dim3(grid), dim3(NTHR), params, LDS_BYTES, stream); }
#elif defined(PROBE_DUP)
    { void* params[] = {&a}; a.coop = 1;
      a.ph_lo = 0; a.ph_hi = PROBE_DUP + 1; hipLaunchCooperativeKernel((const void*)mega_fwd, dim3(grid), dim3(NTHR), params, LDS_BYTES, stream);
      a.li = 1; a.ph_lo = PROBE_DUP; a.ph_hi = PROBE_DUP + 1; hipLaunchCooperativeKernel((const void*)mega_fwd, dim3(grid), dim3(NTHR), params, LDS_BYTES, stream);
      a.li = 2; a.ph_lo = PROBE_DUP + 1; a.ph_hi = NPHASES; hipLaunchCooperativeKernel((const void*)mega_fwd, dim3(grid), dim3(NTHR), params, LDS_BYTES, stream); }
#elif MK_N_LAUNCHES == 1
    a.ph_lo = 0; a.ph_hi = NPHASES; a.coop = 1;
    void* params[] = {&a};
    hipError_t e = hipLaunchCooperativeKernel((const void*)mega_fwd, dim3(grid), dim3(NTHR), params, LDS_BYTES, stream);
    if (e != hipSuccess) fprintf(stderr, "kernel_launch: cooperative launch failed: %s (grid %d)\n", hipGetErrorString(e), grid);
#else
    for (int p = 0; p < NPHASES; ++p) {
        a.ph_lo = p; a.ph_hi = p + 1; a.coop = 0;
        hipLaunchKernelGGL(mega_fwd, dim3(grid), dim3(NTHR), LDS_BYTES, stream, a);
    }
#endif
}
```

```cpp
#include <hip/hip_runtime.h>
#include <hip/hip_cooperative_groups.h>
#include <cstdio>
#include <cstdint>
#include <cmath>
namespace cg = cooperative_groups;

#define LAS __attribute__((address_space(3)))
#define GAS __attribute__((address_space(1)))
typedef unsigned short bf16;
typedef short bf16x8 __attribute__((ext_vector_type(8)));
typedef float f32x2 __attribute__((ext_vector_type(2)));
typedef float f32x4 __attribute__((ext_vector_type(4)));
typedef float f32x16 __attribute__((ext_vector_type(16)));
typedef unsigned u32x2 __attribute__((ext_vector_type(2)));
typedef unsigned u32x4 __attribute__((ext_vector_type(4)));
typedef __bf16 bf16x2_t __attribute__((ext_vector_type(2)));

constexpr int NB = 4, SEQ = 4096, T = NB * SEQ, D = 1024, NH = 8, HD = 64;
constexpr int NZ = 5120;
constexpr int INW = 5128;
constexpr int FF = 2816, NUP = 2 * FF;
constexpr int NWAVES = 8, NTHR = NWAVES * 64;
constexpr float RMS_EPS = 1e-6f;
constexpr float LOG2E = 1.4426950408889634f;
constexpr float QSCALE = 0.125f * LOG2E;
constexpr float NEGBIG = -1e30f;

constexpr size_t MiB = 1u << 20;
constexpr size_t WS_BAR = 0, WS_CNT = 0x10000, WS_BAR_BYTES = 0x20000;
constexpr size_t WS_KH = 0x1C000, WS_FQ = 0x1D000;
constexpr size_t WS_MC = 0x1E000;
constexpr size_t WS_XBUF = 0x300000;
constexpr size_t WS_COS = 0x20000, WS_SIN = 0x40000, WS_LOGF = 0x80000, WS_F = 0x100000, WS_LSE = 0x180000;
constexpr size_t WS_WIN = 4 * MiB, WS_WO = 14 * MiB, WS_WOUT = 16 * MiB, WS_WUP = 18 * MiB, WS_WDN = 29 * MiB;
constexpr size_t WS_QKV = 36 * MiB;
constexpr size_t WS_SGA = 132 * MiB, WS_SGB = 164 * MiB;
constexpr size_t WS_H = 196 * MiB;
constexpr size_t WS_OD = 196 * MiB;
constexpr size_t WS_O2 = 84 * MiB;
constexpr size_t WS_MIXED = 36 * MiB;
constexpr size_t WS_H2 = 198 * MiB;
constexpr size_t WS_M = 100 * MiB;
constexpr size_t WS_NEED = 256 * MiB;

constexpr int RING_BYTES = 131072;
constexpr int LDS_BYTES = 135168;

__device__ __forceinline__ unsigned cvt_pk_bf16(float lo, float hi) { f32x2 v = {lo, hi}; bf16x2_t b = __builtin_convertvector(v, bf16x2_t); return __builtin_bit_cast(unsigned, b); }
__device__ __forceinline__ void st_wt16(void* p, u32x4 v) { asm volatile("global_store_dwordx4 %0, %1, off sc0 sc1\n\ts_nop 1" :: "v"(p), "v"(v) : "memory"); }
__device__ __forceinline__ float bf_lo(unsigned u) { return __uint_as_float(u << 16); }
__device__ __forceinline__ float bf_hi(unsigned u) { return __uint_as_float(u & 0xffff0000u); }
__device__ __forceinline__ float fast_sigmoid(float x) { return __builtin_amdgcn_rcpf(1.0f + __builtin_amdgcn_exp2f(-x * LOG2E)); }
template <int CTRL> __device__ __forceinline__ float dpp_f(float v) {
    return __builtin_bit_cast(float, __builtin_amdgcn_update_dpp(0, __builtin_bit_cast(int, v), CTRL, 0xF, 0xF, false));
}
__device__ __forceinline__ float wave_sum(float v) {
    v += dpp_f<0xB1>(v); v += dpp_f<0x4E>(v); v += dpp_f<0x141>(v); v += dpp_f<0x140>(v);
    v += __shfl_xor(v, 16);
    auto rr = __builtin_amdgcn_permlane32_swap(__float_as_uint(v), __float_as_uint(v), false, false);
    return __uint_as_float(rr[0]) + __uint_as_float(rr[1]);
}

namespace pg8 {
constexpr int BM = 256, BK = 64, HALF = 128, HTB = HALF * BK * 2, STAGE_BYTES = 8 * HTB, NXCD = 8, WGM = 8;
__host__ __device__ __forceinline__ int lds_byte(int r, int c) { const int st = (r >> 4) * 2 + (c >> 5), rr = r & 15, cc = c & 31, ob = rr * 64 + cc * 2; return st * 1024 + (ob ^ (((ob >> 9) & 1) << 5)); }
__host__ __device__ __forceinline__ void stage_rc(int b, int& R, int& C) { const int st = b / 1024, sb = b % 1024, swz = sb ^ (((sb >> 9) & 1) << 5); R = (st >> 1) * 16 + swz / 64; C = (st & 1) * 32 + (swz % 64) / 2; }
__host__ __device__ __forceinline__ int perm32(int rho) { const int n = rho >> 4, i = rho & 15; return 8 * (i >> 2) + 4 * n + (i & 3); }

struct Unit { int pm, pn; };
struct Gemm { const bf16* A; const bf16* Bt; int K; };

struct StaticOrder {
    int nM, nN, nwg, G, c;
    __device__ void init(int nM_, int nN_, int G_, int c_) { nM = nM_; nN = nN_; nwg = nM * nN; G = G_; c = c_; }
    __device__ bool next(int i, Unit& u) const {
        const long L = (long)i * G + c; if (L >= nwg) return false;
        int wgid = (int)L; { const int q = nwg / NXCD, r = nwg % NXCD, xcd = wgid % NXCD, off = wgid / NXCD; wgid = (xcd < r ? xcd * (q + 1) : r * (q + 1) + (xcd - r) * q) + off; }
        const int nig = WGM * nN, gid = wgid / nig, fm = gid * WGM, gsz = (nM - fm) < WGM ? (nM - fm) : WGM;
        u.pm = fm + ((wgid % nig) % gsz); u.pn = (wgid % nig) / gsz; return true;
    }
};

template <class Epi, class Sched>
__device__ __forceinline__ void gemm_phase(LAS unsigned char* lds, const Gemm g, const Sched& S, const Epi& E) {
    const int tid = threadIdx.x, wid = __builtin_amdgcn_readfirstlane(tid >> 6), lane = tid & 63, wr = wid >> 2, wc = wid & 3, fr = lane & 15, fq = lane >> 4;
    const int K = g.K, nt = K / BK;
    constexpr bool HALO = Epi::HALO;
    unsigned voffA[2], voffB[2];
#pragma unroll
    for (int i = 0; i < 2; ++i) { int R, C; stage_rc(tid * 16 + i * 8192, R, C); const int Rb = Epi::PERM ? ((R & ~31) + perm32(R & 31)) : R;
        const int Ra = HALO ? (R - 2 * (R >> 6)) : R;
        voffA[i] = (unsigned)(Ra * K + C) * 2u; voffB[i] = (unsigned)(Rb * K + C) * 2u; }
    const size_t kstep = (size_t)(BK * 2);
    const size_t hstepB = (size_t)HALF * K * 2, tstepB = 2 * hstepB;
    const size_t hstepA = (size_t)(HALO ? 124 : 128) * K * 2, tstepA = 2 * hstepA;
    const char* Abase = (const char*)g.A - (HALO ? (size_t)2 * K * 2 : (size_t)0);
    const unsigned ldsw = (unsigned)wid * 1024u;
    const int aoff = lds_byte(wr * 64 + fr, fq * 8), boff = lds_byte(wc * 32 + fr, fq * 8);
#define PG8_SA(b, h) (((b) * 2 + (h)) * HTB)
#define PG8_SB(b, h) ((4 + (b) * 2 + (h)) * HTB)
#define PG8_STAGE(bufoff, gbase, voff) do { _Pragma("unroll") for (int _i = 0; _i < 2; ++_i) \
        __builtin_amdgcn_global_load_lds((const unsigned*)((const char*)(gbase) + (voff)[_i]), (LAS unsigned*)(lds + (bufoff) + ldsw + _i * 8192), 16, 0, 0); } while (0)
#define PG8_LDA(dst, b, h) do { _Pragma("unroll") for (int m = 0; m < 4; ++m) _Pragma("unroll") for (int k = 0; k < 2; ++k) dst[m][k] = *(const LAS bf16x8*)(lds + PG8_SA(b, h) + aoff + m * 2048 + k * 1024); } while (0)
#define PG8_LDB(dst, b, h) do { _Pragma("unroll") for (int n = 0; n < 2; ++n) _Pragma("unroll") for (int k = 0; k < 2; ++k) dst[n][k] = *(const LAS bf16x8*)(lds + PG8_SB(b, h) + boff + n * 2048 + k * 1024); } while (0)
#define PG8_MMA(ai, bj, At, Bt) do { __builtin_amdgcn_s_setprio(1); _Pragma("unroll") for (int m = 0; m < 4; ++m) _Pragma("unroll") for (int n = 0; n < 2; ++n) _Pragma("unroll") for (int k = 0; k < 2; ++k) \
        acc[ai][bj][m][n] = __builtin_amdgcn_mfma_f32_16x16x32_bf16(Bt[n][k], At[m][k], acc[ai][bj][m][n], 0, 0, 0); __builtin_amdgcn_s_setprio(0); } while (0)
#define PG8_WAIT_V(n) asm volatile("s_waitcnt vmcnt(" #n ")" ::: "memory")
#define PG8_WAIT_L(n) asm volatile("s_waitcnt lgkmcnt(" #n ")" ::: "memory")
#define PG8_BAR __builtin_amdgcn_s_barrier()
#define PG8_SCHED __builtin_amdgcn_sched_barrier(0)
    Unit cur, nxt; int ui = 0;
    if (!S.next(0, cur)) return;
    f32x4 acc[2][2][4][2];
#pragma unroll
    for (int a = 0; a < 2; ++a)
#pragma unroll
        for (int b = 0; b < 2; ++b)
#pragma unroll
            for (int m = 0; m < 4; ++m)
#pragma unroll
                for (int n = 0; n < 2; ++n) acc[a][b][m][n] = (f32x4){0.f, 0.f, 0.f, 0.f};
    bf16x8 At[4][2], B0[2][2], B1[2][2];
    const char* cA = Abase + (size_t)cur.pm * tstepA; const char* cB = (const char*)g.Bt + (size_t)cur.pn * tstepB;
    PG8_STAGE(PG8_SB(0, 0), cB, voffB); PG8_STAGE(PG8_SB(0, 1), cB + hstepB, voffB); PG8_STAGE(PG8_SA(0, 0), cA, voffA); PG8_STAGE(PG8_SA(0, 1), cA + hstepA, voffA);
    if (wr == 1) PG8_BAR;
    PG8_WAIT_V(2); PG8_BAR;
    PG8_STAGE(PG8_SB(1, 0), cB + kstep, voffB); PG8_STAGE(PG8_SA(1, 0), cA + kstep, voffA); PG8_STAGE(PG8_SB(1, 1), cB + hstepB + kstep, voffB);
    PG8_WAIT_V(6); PG8_BAR;
    for (;;) {
        const bool has_next = S.next(ui + 1, nxt);
        const char* nA = has_next ? Abase + (size_t)nxt.pm * tstepA : cA; const char* nB = has_next ? (const char*)g.Bt + (size_t)nxt.pn * tstepB : cB;
        for (int t = 0; t < nt; t += 2) {
            if constexpr (Epi::HAS_MID) { if (t == (nt >> 1)) E.mid(acc, cur, wr, wc, fr, fq); }
            const bool last = (t == nt - 2);
            const char* a1 = cA + (size_t)(t + 1) * kstep;
            const char* a2 = last ? nA : cA + (size_t)(t + 2) * kstep; const char* b2 = last ? nB : cB + (size_t)(t + 2) * kstep;
            const char* a3 = a2 + kstep; const char* b3 = b2 + kstep;
            PG8_LDB(B0, 0, 0); PG8_LDB(B1, 0, 1); PG8_SCHED; PG8_LDA(At, 0, 0); PG8_STAGE(PG8_SA(1, 1), a1 + hstepA, voffA);
            PG8_WAIT_V(8); PG8_WAIT_L(0); PG8_BAR; PG8_MMA(0, 0, At, B0); PG8_MMA(0, 1, At, B1); PG8_BAR; PG8_SCHED;
            PG8_LDA(At, 0, 1); PG8_STAGE(PG8_SB(0, 0), b2, voffB); PG8_STAGE(PG8_SB(0, 1), b2 + hstepB, voffB); PG8_STAGE(PG8_SA(0, 0), a2, voffA);
            PG8_WAIT_V(8); PG8_WAIT_L(0); PG8_BAR; PG8_MMA(1, 0, At, B0); PG8_MMA(1, 1, At, B1); PG8_BAR; PG8_SCHED;
            PG8_LDB(B0, 1, 0); PG8_LDB(B1, 1, 1); PG8_SCHED; PG8_LDA(At, 1, 0); PG8_STAGE(PG8_SA(0, 1), a2 + hstepA, voffA);
            PG8_WAIT_V(8); PG8_WAIT_L(0); PG8_BAR; PG8_MMA(0, 0, At, B0); PG8_MMA(0, 1, At, B1); PG8_BAR; PG8_SCHED;
            PG8_LDA(At, 1, 1); PG8_STAGE(PG8_SB(1, 0), b3, voffB); PG8_STAGE(PG8_SB(1, 1), b3 + hstepB, voffB); PG8_STAGE(PG8_SA(1, 0), a3, voffA);
            PG8_WAIT_V(8); PG8_WAIT_L(0); PG8_BAR; PG8_MMA(1, 0, At, B0); PG8_MMA(1, 1, At, B1); PG8_BAR; PG8_SCHED;
        }
        if (wr == 0) PG8_BAR;
        if constexpr (!Epi::AFTER_DRAIN) E(acc, cur, wr, wc, fr, fq);
        if (!has_next) break;
#pragma unroll
        for (int a = 0; a < 2; ++a)
#pragma unroll
            for (int b = 0; b < 2; ++b)
#pragma unroll
                for (int m = 0; m < 4; ++m)
#pragma unroll
                    for (int n = 0; n < 2; ++n) acc[a][b][m][n] = (f32x4){0.f, 0.f, 0.f, 0.f};
        cur = nxt; cA = nA; cB = nB; ++ui;
        if (wr == 1) PG8_BAR;
    }
    PG8_WAIT_V(0);
    PG8_BAR;
    if constexpr (Epi::AFTER_DRAIN) E.fused(acc, cur, wr, wc, fr, fq, lds, wid, lane);
#undef PG8_SA
#undef PG8_SB
#undef PG8_STAGE
#undef PG8_LDA
#undef PG8_LDB
#undef PG8_MMA
#undef PG8_WAIT_V
#undef PG8_WAIT_L
#undef PG8_BAR
#undef PG8_SCHED
}

struct EpiZ {
    static constexpr bool PERM = true, HALO = false, HAS_MID = false, AFTER_DRAIN = false;
    bf16* qkv; bf16* sga; bf16* sgb; const float* cosT; const float* sinT; unsigned* kh;
    __device__ __forceinline__ void mid(f32x4 (&)[2][2][4][2], const Unit&, int, int, int, int) const {}
    __device__ __forceinline__ void operator()(f32x4 (&acc)[2][2][4][2], const Unit& u, int wr, int wc, int fr, int fq) const {
        if ((u.pn >> 1) == 1) {
#pragma unroll
            for (int bj = 0; bj < 2; ++bj) {
                float mx = 0.f;
#pragma unroll
                for (int ai = 0; ai < 2; ++ai)
#pragma unroll
                    for (int m = 0; m < 4; ++m) { const f32x4 a = acc[ai][bj][m][0], b = acc[ai][bj][m][1];
                        float q = ((a[0] * a[0] + a[1] * a[1]) + (a[2] * a[2] + a[3] * a[3])) + ((b[0] * b[0] + b[1] * b[1]) + (b[2] * b[2] + b[3] * b[3]));
                        q += __shfl_xor(q, 16); q += __shfl_xor(q, 32); mx = fmaxf(mx, q); }
                mx = fmaxf(mx, __shfl_xor(mx, 1)); mx = fmaxf(mx, __shfl_xor(mx, 2)); mx = fmaxf(mx, __shfl_xor(mx, 4)); mx = fmaxf(mx, __shfl_xor(mx, 8));
                if (fr == 0 && fq == 0) { const int head = ((u.pn & 1) * 256 + bj * 128 + wc * 32) >> 6, bb = (u.pm * 256) / SEQ;
                    atomicMax(kh + (bb * NH + head) * 2 + (wc & 1), __float_as_uint(mx)); }
            }
        }
        const int pn = u.pn; bf16* base; int ldc, colt, mode;
        if (pn < 12) { const int reg = pn >> 1; base = qkv + (size_t)reg * T * 512; ldc = 512; colt = (pn & 1) * 256; mode = (reg == 0) ? 1 : (reg == 3) ? 3 : (reg == 4) ? 2 : 0; }
        else if (pn < 16) { base = sga; ldc = 1024; colt = (pn - 12) * 256; mode = 4; }
        else { base = sgb; ldc = 1024; colt = (pn - 16) * 256; mode = 4; }
        const int row0 = u.pm * 256 + wr * 64 + fr, col0 = colt + wc * 32 + 8 * fq;
        const bool rope = (mode & 2) && ((wc & 1) == 0);
        const float sc = (mode & 1) ? QSCALE : 1.0f;
        const float sgn = (fq == 0) ? -1.0f : 1.0f;
        if (rope) {
#pragma unroll
            for (int ai = 0; ai < 2; ++ai)
#pragma unroll
                for (int m = 0; m < 4; ++m) {
                    const int pos = (row0 + ai * 128 + m * 16) & (SEQ - 1);
                    const f32x4 cs0 = *(const f32x4*)(cosT + pos * 8), cs1 = *(const f32x4*)(cosT + pos * 8 + 4), sn0 = *(const f32x4*)(sinT + pos * 8), sn1 = *(const f32x4*)(sinT + pos * 8 + 4);
#pragma unroll
                    for (int bj = 0; bj < 2; ++bj) {
                        f32x4 v0 = acc[ai][bj][m][0], v1 = acc[ai][bj][m][1], p0, p1;
#pragma unroll
                        for (int j = 0; j < 4; ++j) { p0[j] = __shfl_xor(v0[j], 16); p1[j] = __shfl_xor(v1[j], 16); }
                        if (fq < 2) {
#pragma unroll
                            for (int j = 0; j < 4; ++j) { v0[j] = v0[j] * cs0[j] + sgn * p0[j] * sn0[j]; v1[j] = v1[j] * cs1[j] + sgn * p1[j] * sn1[j]; }
                        }
                        acc[ai][bj][m][0] = v0; acc[ai][bj][m][1] = v1;
                    }
                }
        }
#pragma unroll
        for (int ai = 0; ai < 2; ++ai)
#pragma unroll
            for (int m = 0; m < 4; ++m) {
                const int row = row0 + ai * 128 + m * 16;
                bf16* rowp = base + (size_t)row * ldc + col0;
#pragma unroll
                for (int bj = 0; bj < 2; ++bj) {
                    f32x4 v0 = acc[ai][bj][m][0], v1 = acc[ai][bj][m][1];
                    if (mode == 4) {
#pragma unroll
                        for (int j = 0; j < 4; ++j) { v0[j] = fast_sigmoid(v0[j]); v1[j] = fast_sigmoid(v1[j]); }
                    } else {
                        v0 = v0 * sc; v1 = v1 * sc;
                    }
                    u32x4 w; w.x = cvt_pk_bf16(v0[0], v0[1]); w.y = cvt_pk_bf16(v0[2], v0[3]); w.z = cvt_pk_bf16(v1[0], v1[1]); w.w = cvt_pk_bf16(v1[2], v1[3]);
                    if (pn >= 12) __builtin_nontemporal_store(w, (u32x4*)(rowp + bj * 128)); else *(u32x4*)(rowp + bj * 128) = w;
                }
            }
    }
};

struct EpiMix {
    static constexpr bool PERM = true, HALO = false, HAS_MID = true, AFTER_DRAIN = false;
    const bf16* sga; const bf16* sgb; bf16* out;
    __device__ __forceinline__ void mid(f32x4 (&acc)[2][2][4][2], const Unit& u, int wr, int wc, int fr, int fq) const {
        unsigned opq; asm volatile("v_mov_b32 %0, 0" : "=v"(opq));
        const unsigned base = (unsigned)((u.pm * 256 + wr * 64 + fr) * D + u.pn * 256 + wc * 32 + 8 * fq) * 2u + opq;
#pragma unroll
        for (int ai = 0; ai < 2; ++ai)
#pragma unroll
            for (int m = 0; m < 4; ++m) {
                const unsigned off = base + (unsigned)((ai * 128 + m * 16) * D) * 2u;
#pragma unroll
                for (int bj = 0; bj < 2; ++bj) {
                    const u32x4 a = __builtin_nontemporal_load((const u32x4*)((const char*)sga + (off + bj * 256))), b = *(const u32x4*)((const char*)sgb + (off + bj * 256));
                    f32x4 r0, r1;
                    r0[0] = bf_lo(a.x) * __builtin_amdgcn_rcpf(bf_lo(b.x)); r0[1] = bf_hi(a.x) * __builtin_amdgcn_rcpf(bf_hi(b.x));
                    r0[2] = bf_lo(a.y) * __builtin_amdgcn_rcpf(bf_lo(b.y)); r0[3] = bf_hi(a.y) * __builtin_amdgcn_rcpf(bf_hi(b.y));
                    r1[0] = bf_lo(a.z) * __builtin_amdgcn_rcpf(bf_lo(b.z)); r1[1] = bf_hi(a.z) * __builtin_amdgcn_rcpf(bf_hi(b.z));
                    r1[2] = bf_lo(a.w) * __builtin_amdgcn_rcpf(bf_lo(b.w)); r1[3] = bf_hi(a.w) * __builtin_amdgcn_rcpf(bf_hi(b.w));
                    acc[ai][bj][m][0] = acc[ai][bj][m][0] * r0; acc[ai][bj][m][1] = acc[ai][bj][m][1] * r1;
                }
                if (m == 3) asm volatile("" ::: "memory");
            }
    }
    __device__ __forceinline__ void operator()(f32x4 (&acc)[2][2][4][2], const Unit& u, int wr, int wc, int fr, int fq) const {
        const int row0 = u.pm * 256 + wr * 64 + fr, col0 = u.pn * 256 + wc * 32 + 8 * fq;
        u32x4 gbv[2][4][2];
#pragma unroll
        for (int ai = 0; ai < 2; ++ai)
#pragma unroll
            for (int m = 0; m < 4; ++m)
#pragma unroll
                for (int bj = 0; bj < 2; ++bj) gbv[ai][m][bj] = __builtin_nontemporal_load((const u32x4*)(sgb + (size_t)(row0 + ai * 128 + m * 16) * D + col0 + bj * 128));
#pragma unroll
        for (int ai = 0; ai < 2; ++ai)
#pragma unroll
            for (int m = 0; m < 4; ++m) {
                const size_t off = (size_t)(row0 + ai * 128 + m * 16) * D + col0;
#pragma unroll
                for (int bj = 0; bj < 2; ++bj) {
                    const u32x4 b = gbv[ai][m][bj];
                    const f32x4 v0 = acc[ai][bj][m][0], v1 = acc[ai][bj][m][1];
                    u32x4 w;
                    w.x = cvt_pk_bf16(v0[0] * bf_lo(b.x), v0[1] * bf_hi(b.x)); w.y = cvt_pk_bf16(v0[2] * bf_lo(b.y), v0[3] * bf_hi(b.y));
                    w.z = cvt_pk_bf16(v1[0] * bf_lo(b.z), v1[1] * bf_hi(b.z)); w.w = cvt_pk_bf16(v1[2] * bf_lo(b.w), v1[3] * bf_hi(b.w));
                    *(u32x4*)(out + off + bj * 128) = w;
                }
                if (m == 3) asm volatile("" ::: "memory");
            }
    }
};

struct EpiF32 {
    static constexpr bool PERM = false, HALO = false, HAS_MID = false, AFTER_DRAIN = false;
    float* out;
    __device__ __forceinline__ void mid(f32x4 (&)[2][2][4][2], const Unit&, int, int, int, int) const {}
    __device__ __forceinline__ void operator()(f32x4 (&acc)[2][2][4][2], const Unit& u, int wr, int wc, int fr, int fq) const {
        const int row0 = u.pm * 256 + wr * 64 + fr, col0 = u.pn * 256 + wc * 32 + 4 * fq;
#pragma unroll
        for (int ai = 0; ai < 2; ++ai)
#pragma unroll
            for (int m = 0; m < 4; ++m) {
                float* rowp = out + (size_t)(row0 + ai * 128 + m * 16) * D + col0;
#pragma unroll
                for (int bj = 0; bj < 2; ++bj)
#pragma unroll
                    for (int n = 0; n < 2; ++n) *(f32x4*)(rowp + bj * 128 + n * 16) = acc[ai][bj][m][n];
            }
    }
};

template <int CTRL> __device__ __forceinline__ float dpp0_f(float v) {
    return __builtin_bit_cast(float, __builtin_amdgcn_update_dpp(0, __builtin_bit_cast(int, v), CTRL, 0xF, 0xF, true));
}
struct EpiConvGelu {
    static constexpr bool PERM = true, HALO = true, HAS_MID = false, AFTER_DRAIN = false;
    const float* cw; const float* cb; bf16* out;
    __device__ __forceinline__ void mid(f32x4 (&)[2][2][4][2], const Unit&, int, int, int, int) const {}
    __device__ __forceinline__ void operator()(f32x4 (&acc)[2][2][4][2], const Unit& u, int wr, int wc, int fr, int fq) const {
        const int ca0 = u.pn * 128 + wc * 32 + 8 * fq;
        const float f0 = (fr == 0) ? 1.0f : 0.0f, f1 = (fr < 2) ? 1.0f : 0.0f;
        constexpr float GC1 = -1.5957691216057308f * LOG2E, GC2 = GC1 * 0.044715f;
#pragma unroll
        for (int n = 0; n < 2; ++n) {
            const int ca = ca0 + 4 * n;
            const f32x4 wa0 = *(const f32x4*)(cw + ca), wa1 = *(const f32x4*)(cw + NUP + ca), wa2 = *(const f32x4*)(cw + 2 * NUP + ca), ba = *(const f32x4*)(cb + ca);
            const f32x4 wb0 = *(const f32x4*)(cw + FF + ca), wb1 = *(const f32x4*)(cw + NUP + FF + ca), wb2 = *(const f32x4*)(cw + 2 * NUP + FF + ca), bb = *(const f32x4*)(cb + FF + ca);
#pragma unroll
            for (int ai = 0; ai < 2; ++ai) {
                const int s = 2 * ai + wr;
#pragma unroll
                for (int m = 0; m < 4; ++m) {
                    const int li = 16 * m + fr; const int grow = u.pm * 248 + 62 * s + li - 2;
                    const int tpos = grow & (SEQ - 1);
                    const int mp = (m > 0) ? m - 1 : 0;
                    float p1a[4], p2a[4], p1b[4], p2b[4];
#pragma unroll
                    for (int j = 0; j < 4; ++j) {
                        const float xa = acc[ai][0][m][n][j], xb = acc[ai][1][m][n][j], xap = acc[ai][0][mp][n][j], xbp = acc[ai][1][mp][n][j];
                        p1a[j] = dpp_f<0x121>(xap) * f0 + dpp0_f<0x111>(xa); p2a[j] = dpp_f<0x122>(xap) * f1 + dpp0_f<0x112>(xa);
                        p1b[j] = dpp_f<0x121>(xbp) * f0 + dpp0_f<0x111>(xb); p2b[j] = dpp_f<0x122>(xbp) * f1 + dpp0_f<0x112>(xb);
                    }
                    if (__any((int)(tpos < 2))) {
                        const float k1 = (tpos >= 1) ? 1.0f : 0.0f, k2 = (tpos >= 2) ? 1.0f : 0.0f;
#pragma unroll
                        for (int j = 0; j < 4; ++j) { p1a[j] *= k1; p2a[j] *= k2; p1b[j] *= k1; p2b[j] *= k2; }
                    }
                    float o[4];
#pragma unroll
                    for (int j = 0; j < 4; ++j) {
                        const float xa = acc[ai][0][m][n][j], xb = acc[ai][1][m][n][j];
                        const float va = wa0[j] * p2a[j] + (wa1[j] * p1a[j] + (wa2[j] * xa + ba[j]));
                        const float vb = wb0[j] * p2b[j] + (wb1[j] * p1b[j] + (wb2[j] * xb + bb[j]));
                        const float e = __builtin_amdgcn_exp2f(va * (GC1 + GC2 * (va * va)));
                        o[j] = va * vb * __builtin_amdgcn_rcpf(1.0f + e);
                    }
                    if (li >= 2 && grow < T) { u32x2 w; w.x = cvt_pk_bf16(o[0], o[1]); w.y = cvt_pk_bf16(o[2], o[3]); *(u32x2*)(out + (size_t)grow * FF + ca) = w; }
                }
            }
        }
    }
};

struct PanelSS {
    unsigned* xbuf;
    unsigned* cnt;
    __device__ __forceinline__ void run(const f32x4 (&v)[2][2][4][2], const Unit& u, int wr, int wc, int fr, int fq, LAS unsigned char* lds, int wid, int lane) const {
        LAS float* P = (LAS float*)lds;
        LAS float* S = (LAS float*)(lds + 4096);
#pragma unroll
        for (int ai = 0; ai < 2; ++ai)
#pragma unroll
            for (int m = 0; m < 4; ++m) {
                float q = 0.f;
#pragma unroll
                for (int bj = 0; bj < 2; ++bj)
#pragma unroll
                    for (int n = 0; n < 2; ++n) { const f32x4 x = v[ai][bj][m][n]; q += (x[0] * x[0] + x[1] * x[1]) + (x[2] * x[2] + x[3] * x[3]); }
                q += __shfl_xor(q, 16); q += __shfl_xor(q, 32);
                if (fq == 0) P[(ai * 128 + wr * 64 + m * 16 + fr) * 4 + wc] = q;
            }
        asm volatile("s_waitcnt lgkmcnt(0)" ::: "memory"); __builtin_amdgcn_s_barrier(); asm volatile("" ::: "memory");
        const int row = wid * 32 + (lane & 31);
        if (lane < 32) {
            const float t = (P[row * 4 + 0] + P[row * 4 + 1]) + (P[row * 4 + 2] + P[row * 4 + 3]);
            __hip_atomic_store(xbuf + ((size_t)(u.pm * 256 + row) * 4 + u.pn), __float_as_uint(t), __ATOMIC_RELAXED, __HIP_MEMORY_SCOPE_AGENT);
        }
        asm volatile("s_waitcnt vmcnt(0)" ::: "memory");
        if (lane == 0) __hip_atomic_fetch_add(cnt + 64 * u.pm, 1u, __ATOMIC_RELAXED, __HIP_MEMORY_SCOPE_AGENT);
        if (wid == 0) {
            unsigned sp = 0;
            for (;;) {
                if ((unsigned)__builtin_amdgcn_readfirstlane(__hip_atomic_load(cnt + 64 * u.pm, __ATOMIC_RELAXED, __HIP_MEMORY_SCOPE_AGENT)) >= 32u) break;
                if (++sp > (1u << 22)) break;
                __builtin_amdgcn_s_sleep(2);
            }
            __builtin_amdgcn_fence(__ATOMIC_ACQUIRE, "agent");
        }
        asm volatile("s_waitcnt vmcnt(0) lgkmcnt(0)" ::: "memory"); __builtin_amdgcn_s_barrier(); asm volatile("" ::: "memory");
        if (lane < 32) {
            const unsigned* slot = xbuf + (size_t)(u.pm * 256 + row) * 4; float t = 0.f;
#pragma unroll
            for (int k = 0; k < 4; ++k) t += __uint_as_float(__hip_atomic_load(slot + k, __ATOMIC_RELAXED, __HIP_MEMORY_SCOPE_AGENT));
            S[row] = 1.0f / sqrtf(t * (1.0f / 1024.0f) + RMS_EPS);
        }
        asm volatile("s_waitcnt lgkmcnt(0)" ::: "memory"); __builtin_amdgcn_s_barrier(); asm volatile("" ::: "memory");
    }
};
struct EpiNormA {
    static constexpr bool PERM = false, HALO = false, HAS_MID = false, AFTER_DRAIN = true;
    const float* x; float* out; bf16* h2; const float* g1; const float* g2; PanelSS st1, st2;
    __device__ __forceinline__ void mid(f32x4 (&)[2][2][4][2], const Unit&, int, int, int, int) const {}
    __device__ __forceinline__ void fused(f32x4 (&acc)[2][2][4][2], const Unit& u, int wr, int wc, int fr, int fq, LAS unsigned char* lds, int wid, int lane) const {
        const LAS float* S = (const LAS float*)(lds + 4096);
        const int col0 = u.pn * 256 + wc * 32 + 4 * fq;
        f32x4 pre[4][2][2];
#pragma unroll
        for (int m = 0; m < 4; ++m) { const size_t off = (size_t)(u.pm * 256 + wr * 64 + m * 16 + fr) * D + col0;
#pragma unroll
            for (int bj = 0; bj < 2; ++bj)
#pragma unroll
                for (int n = 0; n < 2; ++n) pre[m][bj][n] = __builtin_nontemporal_load((const f32x4*)(x + off + bj * 128 + n * 16)); }
        st1.run(acc, u, wr, wc, fr, fq, lds, wid, lane);
        f32x4 gv[2][2];
#pragma unroll
        for (int bj = 0; bj < 2; ++bj)
#pragma unroll
            for (int n = 0; n < 2; ++n) gv[bj][n] = *(const f32x4*)(g1 + col0 + bj * 128 + n * 16);
#pragma unroll
        for (int ai = 0; ai < 2; ++ai)
#pragma unroll
            for (int m = 0; m < 4; ++m) { const int r = ai * 128 + wr * 64 + m * 16 + fr; const float inv = S[r]; const size_t off = (size_t)(u.pm * 256 + r) * D + col0;
#pragma unroll
                for (int bj = 0; bj < 2; ++bj)
#pragma unroll
                    for (int n = 0; n < 2; ++n) { const f32x4 xv = (ai == 0) ? pre[m][bj][n] : __builtin_nontemporal_load((const f32x4*)(x + off + bj * 128 + n * 16)); acc[ai][bj][m][n] = xv + acc[ai][bj][m][n] * inv * gv[bj][n]; }
                asm volatile("" : "+v"(acc[ai][0][m][0]), "+v"(acc[ai][0][m][1]), "+v"(acc[ai][1][m][0]), "+v"(acc[ai][1][m][1]));
                if (m & 1) asm volatile("" ::: "memory"); }
        st2.run(acc, u, wr, wc, fr, fq, lds, wid, lane);
#pragma unroll
        for (int bj = 0; bj < 2; ++bj)
#pragma unroll
            for (int n = 0; n < 2; ++n) gv[bj][n] = *(const f32x4*)(g2 + col0 + bj * 128 + n * 16);
#pragma unroll
        for (int ai = 0; ai < 2; ++ai)
#pragma unroll
            for (int m = 0; m < 4; ++m) { const int r = ai * 128 + wr * 64 + m * 16 + fr; const float inv = S[r]; const size_t off = (size_t)(u.pm * 256 + r) * D + col0;
#pragma unroll
                for (int bj = 0; bj < 2; ++bj)
#pragma unroll
                    for (int n = 0; n < 2; ++n) { const f32x4 x1 = acc[ai][bj][m][n]; __builtin_nontemporal_store(x1, (f32x4*)(out + off + bj * 128 + n * 16));
                        const f32x4 o = x1 * inv * gv[bj][n]; u32x2 w; w.x = cvt_pk_bf16(o[0], o[1]); w.y = cvt_pk_bf16(o[2], o[3]); *(u32x2*)(h2 + off + bj * 128 + n * 16) = w; }
                asm volatile("" ::: "memory"); }
    }
};
struct EpiNormB {
    static constexpr bool PERM = false, HALO = false, HAS_MID = false, AFTER_DRAIN = true;
    const float* base; float* out; const float* g; PanelSS st;
    __device__ __forceinline__ void mid(f32x4 (&)[2][2][4][2], const Unit&, int, int, int, int) const {}
    __device__ __forceinline__ void fused(f32x4 (&acc)[2][2][4][2], const Unit& u, int wr, int wc, int fr, int fq, LAS unsigned char* lds, int wid, int lane) const {
        const LAS float* S = (const LAS float*)(lds + 4096);
        const int col0 = u.pn * 256 + wc * 32 + 4 * fq;
        f32x4 pre[4][2][2];
#pragma unroll
        for (int m = 0; m < 4; ++m) { const size_t off = (size_t)(u.pm * 256 + wr * 64 + m * 16 + fr) * D + col0;
#pragma unroll
            for (int bj = 0; bj < 2; ++bj)
#pragma unroll
                for (int n = 0; n < 2; ++n) pre[m][bj][n] = __builtin_nontemporal_load((const f32x4*)(base + off + bj * 128 + n * 16)); }
        st.run(acc, u, wr, wc, fr, fq, lds, wid, lane);
        f32x4 gv[2][2];
#pragma unroll
        for (int bj = 0; bj < 2; ++bj)
#pragma unroll
            for (int n = 0; n < 2; ++n) gv[bj][n] = *(const f32x4*)(g + col0 + bj * 128 + n * 16);
#pragma unroll
        for (int ai = 0; ai < 2; ++ai)
#pragma unroll
            for (int m = 0; m < 4; ++m) { const int r = ai * 128 + wr * 64 + m * 16 + fr; const float inv = S[r]; const size_t off = (size_t)(u.pm * 256 + r) * D + col0;
#pragma unroll
                for (int bj = 0; bj < 2; ++bj)
#pragma unroll
                    for (int n = 0; n < 2; ++n) { const f32x4 bs = (ai == 0) ? pre[m][bj][n] : __builtin_nontemporal_load((const f32x4*)(base + off + bj * 128 + n * 16)); __builtin_nontemporal_store(bs + acc[ai][bj][m][n] * inv * gv[bj][n], (f32x4*)(out + off + bj * 128 + n * 16)); }
                if (m & 1) asm volatile("" ::: "memory"); }
    }
};
}

constexpr int A_BUF = 23552, A_KX = 9216, A_V = 11264, A_VP = 192;
constexpr float A_THR = 8.0f;
__device__ __forceinline__ int crow(int r, int hi) { return (r & 3) + 8 * (r >> 2) + 4 * hi; }
#define MFMA32(a, b, c) __builtin_amdgcn_mfma_f32_32x32x16_bf16((a), (b), (c), 0, 0, 0)
typedef short v4i16_t __attribute__((ext_vector_type(4)));
__device__ __forceinline__ v4i16_t vtr(LAS const unsigned char* p) { return __builtin_amdgcn_ds_read_tr16_b64_v4i16((LAS v4i16_t*)p); }
__device__ __forceinline__ float swap_max(float v) { auto rr = __builtin_amdgcn_permlane32_swap(__float_as_uint(v), __float_as_uint(v), false, false); return fmaxf(__uint_as_float(rr[0]), __uint_as_float(rr[1])); }
__device__ __forceinline__ float swap_sum(float v) { auto rr = __builtin_amdgcn_permlane32_swap(__float_as_uint(v), __float_as_uint(v), false, false); return __uint_as_float(rr[0]) + __uint_as_float(rr[1]); }

struct AttnAcc { f32x16 o0, o1, negm; float m, l; bool first; };
__device__ __forceinline__ void attn_init(AttnAcc& st) {
#pragma unroll
    for (int r = 0; r < 16; ++r) { st.o0[r] = 0.f; st.o1[r] = 0.f; st.negm[r] = 0.f; }
    st.m = 0.f; st.l = 0.f; st.first = true;
}

template <int MODE, bool BIAS>
__device__ __forceinline__ void attn_tile(AttnAcc& st, const bf16x8 (&qr)[4], const bf16x8 qx, LAS const unsigned char* Ks, LAS const unsigned char* Vs,
                                          int r32, int hi, int lane, int qidx, int k0, bool domask) {
    f32x16 p0, p1;
    LAS const unsigned char* kp = Ks + r32 * 144 + hi * 16;
    {
        const bf16x8 k0f = *(LAS const bf16x8*)(kp), k1f = *(LAS const bf16x8*)(kp + 32 * 144);
        p0 = MFMA32(k0f, qr[0], st.negm); p1 = MFMA32(k1f, qr[0], st.negm);
    }
#pragma unroll
    for (int d0 = 1; d0 < 4; ++d0) {
        const bf16x8 k0f = *(LAS const bf16x8*)(kp + d0 * 32), k1f = *(LAS const bf16x8*)(kp + 32 * 144 + d0 * 32);
        p0 = MFMA32(k0f, qr[d0], p0); p1 = MFMA32(k1f, qr[d0], p1);
    }
    if (BIAS) {
        LAS const unsigned char* xp = Ks + A_KX + r32 * 32 + hi * 16;
        const bf16x8 x0 = *(LAS const bf16x8*)(xp), x1 = *(LAS const bf16x8*)(xp + 32 * 32);
        p0 = MFMA32(x0, qx, p0); p1 = MFMA32(x1, qx, p1);
    }
    LAS const unsigned char* vp = Vs + (4 * hi + ((lane & 15) >> 2)) * A_VP + (16 * ((lane >> 4) & 1) + 4 * (lane & 3)) * 2;
    v4i16_t va0[4], va1[4], vb0[4], vb1[4];
#pragma unroll
    for (int c = 0; c < 4; ++c) { va0[c] = vtr(vp + (16 * c) * A_VP); va1[c] = vtr(vp + (16 * c + 8) * A_VP); vb0[c] = vtr(vp + (16 * c) * A_VP + 64); vb1[c] = vtr(vp + (16 * c + 8) * A_VP + 64); }
    if (MODE == 1) {
        if (domask)
#pragma unroll
        for (int r = 0; r < 16; ++r) { const int kv = k0 + crow(r, hi); if (kv > qidx) p0[r] = NEGBIG; if (kv + 32 > qidx) p1[r] = NEGBIG; }
    } else if (MODE == 2) {
#pragma unroll
        for (int r = 0; r < 16; ++r) { const int dist = qidx - (k0 + crow(r, hi)); if ((unsigned)dist > 128u) p0[r] = NEGBIG; if ((unsigned)(dist - 32) > 128u) p1[r] = NEGBIG; }
    }
    float rm = fmaxf(fmaxf(p0[0], p1[0]), fmaxf(p0[1], p1[1]));
#pragma unroll
    for (int r = 2; r < 16; r += 2) rm = fmaxf(fmaxf(rm, p0[r]), fmaxf(fmaxf(p1[r], p0[r + 1]), p1[r + 1]));
    rm = swap_max(rm);
    if (__any((int)(st.first || rm > A_THR))) {
        const float dl = st.first ? fmaxf(rm, -64.0f) : fmaxf(rm, 0.0f);
        st.m += dl;
#pragma unroll
        for (int r = 0; r < 16; ++r) { p0[r] -= dl; p1[r] -= dl; }
        const float nm = -st.m;
#pragma unroll
        for (int r = 0; r < 16; ++r) st.negm[r] = nm;
        const float f = __builtin_amdgcn_exp2f(-dl);
        st.l *= f;
#pragma unroll
        for (int r = 0; r < 16; ++r) { st.o0[r] *= f; st.o1[r] *= f; }
        st.first = false;
    }
    float ls = 0.f;
#pragma unroll
    for (int r = 0; r < 16; ++r) { p0[r] = __builtin_amdgcn_exp2f(p0[r]); p1[r] = __builtin_amdgcn_exp2f(p1[r]); ls += p0[r] + p1[r]; }
    st.l += ls;
#pragma unroll
    for (int c = 0; c < 4; ++c) {
        u32x4 pw;
        if (c == 0) { pw.x = cvt_pk_bf16(p0[0], p0[1]); pw.y = cvt_pk_bf16(p0[2], p0[3]); pw.z = cvt_pk_bf16(p0[4], p0[5]); pw.w = cvt_pk_bf16(p0[6], p0[7]); }
        else if (c == 1) { pw.x = cvt_pk_bf16(p0[8], p0[9]); pw.y = cvt_pk_bf16(p0[10], p0[11]); pw.z = cvt_pk_bf16(p0[12], p0[13]); pw.w = cvt_pk_bf16(p0[14], p0[15]); }
        else if (c == 2) { pw.x = cvt_pk_bf16(p1[0], p1[1]); pw.y = cvt_pk_bf16(p1[2], p1[3]); pw.z = cvt_pk_bf16(p1[4], p1[5]); pw.w = cvt_pk_bf16(p1[6], p1[7]); }
        else { pw.x = cvt_pk_bf16(p1[8], p1[9]); pw.y = cvt_pk_bf16(p1[10], p1[11]); pw.z = cvt_pk_bf16(p1[12], p1[13]); pw.w = cvt_pk_bf16(p1[14], p1[15]); }
        const bf16x8 pb = __builtin_bit_cast(bf16x8, pw);
        const v4i16_t a0 = va0[c], a1 = va1[c], b0 = vb0[c], b1 = vb1[c];
        const bf16x8 v0f = (bf16x8){a0[0], a0[1], a0[2], a0[3], a1[0], a1[1], a1[2], a1[3]};
        const bf16x8 v1f = (bf16x8){b0[0], b0[1], b0[2], b0[3], b1[0], b1[1], b1[2], b1[3]};
        st.o0 = MFMA32(v0f, pb, st.o0); st.o1 = MFMA32(v1f, pb, st.o1);
    }
}

#define ATT_STORE(buf) do { \
    *(LAS u32x4*)(lds + (buf) * A_BUF + srow * 144 + sch * 16) = kreg; \
    *(LAS u32x4*)(lds + (buf) * A_BUF + A_V + srow * A_VP + sch * 16) = vreg; } while (0)

__device__ __forceinline__ void attn_finish(AttnAcc& st, bf16* orow, int hi, float* lse_out) {
    const float l = swap_sum(st.l);
    const float inv = 1.0f / l;
#pragma unroll
    for (int g4 = 0; g4 < 4; ++g4) {
        u32x2 w0, w1;
        w0.x = cvt_pk_bf16(st.o0[4 * g4] * inv, st.o0[4 * g4 + 1] * inv); w0.y = cvt_pk_bf16(st.o0[4 * g4 + 2] * inv, st.o0[4 * g4 + 3] * inv);
        w1.x = cvt_pk_bf16(st.o1[4 * g4] * inv, st.o1[4 * g4 + 1] * inv); w1.y = cvt_pk_bf16(st.o1[4 * g4 + 2] * inv, st.o1[4 * g4 + 3] * inv);
        *(u32x2*)(orow + 8 * g4 + 4 * hi) = w0; *(u32x2*)(orow + 32 + 8 * g4 + 4 * hi) = w1;
    }
    if (lse_out && hi == 0) *lse_out = st.m + __builtin_amdgcn_logf(l);
}

__device__ __forceinline__ u32x4 bias_terms(float b) {
    const unsigned h = cvt_pk_bf16(b, 0.f) & 0xffffu; const float r1 = b - __uint_as_float(h << 16);
    const unsigned m = cvt_pk_bf16(r1, 0.f) & 0xffffu; const float r2 = r1 - __uint_as_float(m << 16);
    const unsigned l = cvt_pk_bf16(r2, 0.f) & 0xffffu;
    return (u32x4){h | (m << 16), l, 0u, 0u};
}

__device__ __forceinline__ void fox_unit(LAS unsigned char* lds, int b, int h, int qb, const bf16* QA, const bf16* KA, const bf16* VA, const float* Fall, bf16* O2, const unsigned* khp) {
    const int tid = threadIdx.x, lane = tid & 63, r32 = lane & 31, hi = lane >> 5, wid = __builtin_amdgcn_readfirstlane(tid >> 6);
    const int srow = tid >> 3, sch = tid & 7;
    const long rowbase = (long)b * SEQ; const int q0 = qb * 256;
    const float* Fh = Fall + (size_t)(b * NH + h) * SEQ;
    const float fref = Fh[q0];
    const bf16* Kh = KA + rowbase * 512 + h * 64 + 8 * sch; const bf16* Vh = VA + rowbase * 512 + h * 64 + 8 * sch;
    const int qidx = q0 + wid * 32 + r32;
    bf16x8 qr[4];
    { const bf16* qp = QA + (rowbase + qidx) * 512 + h * 64 + hi * 8;
#pragma unroll
      for (int d0 = 0; d0 < 4; ++d0) qr[d0] = __builtin_nontemporal_load((const bf16x8*)(qp + d0 * 16)); }
    const short one = (hi == 0) ? (short)0x3F80 : (short)0;
    const bf16x8 qx = (bf16x8){one, one, one, 0, 0, 0, 0, 0};
    AttnAcc st; attn_init(st);
    const int NT = 4 * (qb + 1);
    int t0 = 0;
    {
        float qq = 0.f;
#pragma unroll
        for (int d0 = 0; d0 < 4; ++d0)
#pragma unroll
            for (int e = 0; e < 8; ++e) { const float f = __uint_as_float(((unsigned)(unsigned short)qr[d0][e]) << 16); qq += f * f; }
        qq = swap_sum(qq);
        qq = fmaxf(qq, __shfl_xor(qq, 1)); qq = fmaxf(qq, __shfl_xor(qq, 2)); qq = fmaxf(qq, __shfl_xor(qq, 4)); qq = fmaxf(qq, __shfl_xor(qq, 8)); qq = fmaxf(qq, __shfl_xor(qq, 16));
        LAS float* ctl = (LAS float*)(lds + 48000);
        if (lane == 0) ctl[wid] = qq;
        __syncthreads();
        float q2 = ctl[0];
#pragma unroll
        for (int w = 1; w < 8; ++w) q2 = fmaxf(q2, ctl[w]);
        const float k2 = __uint_as_float(khp[(b * NH + h) * 2]) + __uint_as_float(khp[(b * NH + h) * 2 + 1]);
        const float thr = 150.0f + 2.04f * sqrtf(q2 * k2);
        const bool skip = (lane < 4 * qb) && ((fref - Fh[64 * lane + 63]) * LOG2E < -thr);
        t0 = __popcll(__ballot(skip));
    }
    u32x4 kreg, vreg; float breg = 0.f;
    { const size_t ro = (size_t)(64 * (NT - 1) + srow) * 512; kreg = *(const u32x4*)(Kh + ro); vreg = *(const u32x4*)(Vh + ro); if (tid < 64) breg = (fref - Fh[64 * (NT - 1) + tid]) * LOG2E; }
    const int qmin = q0 + wid * 32, qmax = qmin + 31;
    for (int t = NT - 1; t >= t0; --t) {
        const int buf = t & 1;
        ATT_STORE(buf);
        if (tid < 64) { LAS u32x4* xp = (LAS u32x4*)(lds + buf * A_BUF + A_KX + tid * 32); xp[0] = bias_terms(breg); xp[1] = (u32x4){0u, 0u, 0u, 0u}; }
        __syncthreads();
        if (t > t0) { const size_t ro = (size_t)(64 * (t - 1) + srow) * 512; kreg = *(const u32x4*)(Kh + ro); vreg = *(const u32x4*)(Vh + ro); if (tid < 64) breg = (fref - Fh[64 * (t - 1) + tid]) * LOG2E; }
        const int k0 = 64 * t;
        if (k0 <= qmax) {
            LAS const unsigned char* Ks = lds + buf * A_BUF; LAS const unsigned char* Vs = lds + buf * A_BUF + A_V;
            attn_tile<1, true>(st, qr, qx, Ks, Vs, r32, hi, lane, qidx, k0, k0 + 63 > qmin);
        }
    }
    attn_finish(st, O2 + (rowbase + qidx) * 1024 + h * 64, hi, nullptr);
    __syncthreads();
}

constexpr int DL_V = 384 * 144;
struct DilU { int g, b, h, r, u, d; };
__device__ __forceinline__ DilU dil_decode(int id) {
    DilU U; U.g = id / 512; const int rest = id % 512, bh = rest >> 4, idx = rest & 15; U.b = bh >> 3; U.h = bh & 7;
    if (U.g == 0) { U.r = 0; U.u = idx; U.d = 1; } else if (U.g == 1) { U.r = idx & 3; U.u = idx >> 2; U.d = 4; } else { U.r = idx; U.u = 0; U.d = 16; }
    return U;
}
__device__ __forceinline__ void dil_phase(LAS unsigned char* lds, int bx, int G, const bf16* QB, const bf16* KB, const bf16* VB, bf16* OD, float* LSE) {
    const int tid = threadIdx.x, lane = tid & 63, r32 = lane & 31, hi = lane >> 5, wid = __builtin_amdgcn_readfirstlane(tid >> 6);
    const int srow = tid >> 3, sch = tid & 7;
    constexpr int NU = 3 * 32 * 16;
    if (bx >= NU) return;
    u32x4 kreg[6], vreg[6]; bf16x8 qn[4];
#define DIL_LOAD(U) do { const long rb_ = (long)(U).b * SEQ; const int kb_ = 256 * (U).u - 128, j0_ = ((U).u == 0) ? 2 : 0; \
        _Pragma("unroll") for (int j = 0; j < 6; ++j) { if (j >= j0_) { const size_t ro_ = (size_t)(rb_ + (long)(kb_ + 64 * j + srow) * (U).d + (U).r) * 512 + (U).h * 64 + 8 * sch; \
            kreg[j] = *(const u32x4*)(KB + ro_); vreg[j] = *(const u32x4*)(VB + ro_); } } \
        const bf16* qp_ = QB + (size_t)(rb_ + (long)(256 * (U).u + wid * 32 + r32) * (U).d + (U).r) * 512 + (U).h * 64 + hi * 8; \
        _Pragma("unroll") for (int d0 = 0; d0 < 4; ++d0) qn[d0] = *(const bf16x8*)(qp_ + d0 * 16); } while (0)
    DilU U = dil_decode(bx);
    DIL_LOAD(U);
    const bf16x8 qx = (bf16x8){0, 0, 0, 0, 0, 0, 0, 0};
    for (int id = bx; id < NU; id += G) {
        const int j0 = (U.u == 0) ? 2 : 0;
#pragma unroll
        for (int j = 0; j < 6; ++j) { if (j >= j0) { *(LAS u32x4*)(lds + (64 * j + srow) * 144 + sch * 16) = kreg[j]; *(LAS u32x4*)(lds + DL_V + (64 * j + srow) * A_VP + sch * 16) = vreg[j]; } }
        bf16x8 qr[4];
#pragma unroll
        for (int d0 = 0; d0 < 4; ++d0) qr[d0] = qn[d0];
        __syncthreads();
        const DilU C = U;
        if (id + G < NU) { U = dil_decode(id + G); DIL_LOAD(U); }
        AttnAcc st; attn_init(st);
        const int kbase = 256 * C.u - 128, qlo = 256 * C.u + wid * 32, qs = qlo + r32;
#pragma unroll 1
        for (int j = j0; j < 6; ++j) {
            const int k0 = kbase + 64 * j;
            if (k0 + 63 >= qlo - 128 && k0 <= qlo + 31)
                attn_tile<2, false>(st, qr, qx, lds + j * (64 * 144), lds + DL_V + j * (64 * A_VP), r32, hi, lane, qs, k0, true);
        }
        const long qrow = (long)C.b * SEQ + (long)qs * C.d + C.r;
        attn_finish(st, OD + ((size_t)C.g * T + qrow) * 512 + C.h * 64, hi, LSE + ((size_t)C.g * T + qrow) * NH + C.h);
        __syncthreads();
    }
#undef DIL_LOAD
}

#define XB_TMO      128
#define XB_XCNT(j)  (256  + 64 * (j))
#define XB_XSUB(j)  (1280 + 64 * (j))
#define XB_XGEN(j)  (2304 + 64 * (j))
#define XB_TOP      3328
#define XB_TOPGEN   3392
#define XCD_BAR_WORDS 3456
#define XB_SPIN_CAP (1u << 22)
__device__ __forceinline__ unsigned xb_ld(unsigned* p)              { return __hip_atomic_load(p, __ATOMIC_RELAXED, __HIP_MEMORY_SCOPE_AGENT); }
__device__ __forceinline__ unsigned xb_add(unsigned* p, unsigned v) { return __hip_atomic_fetch_add(p, v, __ATOMIC_RELAXED, __HIP_MEMORY_SCOPE_AGENT); }
__device__ __forceinline__ unsigned xb_xcc_id() { return (unsigned)__builtin_amdgcn_s_getreg((3 << 11) | 20) & 0xFu; }
#define XB_SPIN(cond, bar) do { unsigned _sp = 0; while (cond) { __builtin_amdgcn_s_sleep(1); \
    if ((++_sp & 255u) == 0u) { if (xb_ld(&(bar)[XB_TMO])) break; if (_sp > XB_SPIN_CAP) { atomicAdd(&(bar)[XB_TMO], 1u); break; } } } } while (0)
struct XcdBarrier { unsigned* bar; unsigned x; volatile LAS unsigned* st; };
__device__ __forceinline__ XcdBarrier xcd_barrier_post(unsigned* bar, volatile LAS unsigned* st) {
    XcdBarrier b; b.bar = bar; b.x = xb_xcc_id(); b.st = st;
    if (threadIdx.x == 0) (void)xb_add(&bar[XB_XCNT(b.x)], 1u);
    return b;
}
__device__ __forceinline__ void xcd_barrier_complete(unsigned* bar, unsigned x, unsigned& nloc, unsigned& nx) {
    const unsigned G = gridDim.x * gridDim.y * gridDim.z;
    unsigned sum, cnt, mine, sp = 0u;
    for (;;) {
        sum = 0u; cnt = 0u; mine = 0u;
#pragma unroll
        for (unsigned j = 0; j < 16; ++j) { const unsigned c = xb_ld(&bar[XB_XCNT(j)]); sum += c; cnt += (c > 0u) ? 1u : 0u; mine = (j == x) ? c : mine; }
        if (sum == G) break;
        __builtin_amdgcn_s_sleep(1);
        if ((++sp & 255u) == 0u) { if (xb_ld(&bar[XB_TMO])) break; if (sp > XB_SPIN_CAP) { atomicAdd(&bar[XB_TMO], 1u); break; } }
    }
    nloc = mine > 0u ? mine : 1u; nx = cnt > 0u ? cnt : 1u;
}
__device__ __forceinline__ void xcd_barrier(const XcdBarrier& b) {
    asm volatile("s_waitcnt vmcnt(0)" ::: "memory");
    __syncthreads();
    if (threadIdx.x == 0) {
        unsigned* bar = b.bar;
        __builtin_amdgcn_s_waitcnt(0);
        unsigned nloc = b.st[0], nx = b.st[1];
        if (nloc == 0u) { xcd_barrier_complete(bar, b.x, nloc, nx); b.st[0] = nloc; b.st[1] = nx; }
        const unsigned old = xb_add(&bar[XB_XSUB(b.x)], 1u);
        const unsigned gen = old / nloc;
        if (old + 1u == (gen + 1u) * nloc) {
            __builtin_amdgcn_fence(__ATOMIC_RELEASE, "agent");
            asm volatile("s_waitcnt vmcnt(0)" ::: "memory");
            const unsigned og = xb_add(&bar[XB_TOP], 1u);
            const unsigned tg = og / nx;
            if (og + 1u == (tg + 1u) * nx) xb_add(&bar[XB_TOPGEN], 1u);
            else XB_SPIN(xb_ld(&bar[XB_TOPGEN]) == tg, bar);
            __builtin_amdgcn_fence(__ATOMIC_ACQUIRE, "agent");
            xb_add(&bar[XB_XGEN(b.x)], 1u);
            asm volatile("s_waitcnt vmcnt(0)" ::: "memory");
        } else {
            XB_SPIN(xb_ld(&bar[XB_XGEN(b.x)]) == gen, bar);
            __builtin_amdgcn_fence(__ATOMIC_ACQUIRE, "agent");
            asm volatile("s_waitcnt vmcnt(0)" ::: "memory");
        }
    }
    __syncthreads();
}

struct Args {
    const float* in[14]; float* out; unsigned char* ws; double invf[8]; int ph_lo, ph_hi; int coop, li;
};

__device__ __forceinline__ void p0_transpose_item(const float* W, int ldw, int k0, int c0, bf16* WT, int ldt, int drow0, int dk0, LAS float* scr, int lane) {
    float tmp[32];
#pragma unroll
    for (int i = 0; i < 32; ++i) { const int kk = 2 * i + (lane >> 5); tmp[i] = __builtin_nontemporal_load(&W[(size_t)(k0 + kk) * ldw + c0 + (lane & 31)]); }
#pragma unroll
    for (int i = 0; i < 32; ++i) { const int kk = 2 * i + (lane >> 5); scr[kk * 33 + (lane & 31)] = tmp[i]; }
    asm volatile("s_waitcnt lgkmcnt(0)" ::: "memory");
    const int c = lane & 7;
#pragma unroll
    for (int j = 0; j < 4; ++j) { const int n = (lane >> 3) + 8 * j; const LAS float* s = scr + (8 * c) * 33 + n;
        u32x4 o; o.x = cvt_pk_bf16(s[0 * 33], s[1 * 33]); o.y = cvt_pk_bf16(s[2 * 33], s[3 * 33]); o.z = cvt_pk_bf16(s[4 * 33], s[5 * 33]); o.w = cvt_pk_bf16(s[6 * 33], s[7 * 33]);
        *(u32x4*)(WT + (size_t)(drow0 + n) * ldt + dk0 + 8 * c) = o; }
    asm volatile("s_waitcnt lgkmcnt(0)" ::: "memory");
}

__global__ void __launch_bounds__(NTHR, 2) mega_fwd(Args args) {
    extern __shared__ __attribute__((aligned(16))) unsigned char lds_raw[];
    LAS unsigned char* lds = (LAS unsigned char*)lds_raw;
    const int tid = threadIdx.x, lane = tid & 63, wave = __builtin_amdgcn_readfirstlane(tid >> 6);
    const int G = gridDim.x, bx = blockIdx.x;
    const int gw = bx * NWAVES + wave, NGW = G * NWAVES;
    unsigned char* ws = args.ws;
    const float* x = args.in[0]; const float* g_pre_mix = args.in[1]; const float* w_in = args.in[2]; const float* b_forget = args.in[3];
    const float* w_o_fox = args.in[4]; const float* w_o_dil = args.in[5]; const float* w_out = args.in[6]; const float* g_post_mix = args.in[7];
    const float* g_pre_ffn = args.in[8]; const float* w_up = args.in[9]; const float* conv_w = args.in[10]; const float* conv_b = args.in[11];
    const float* w_down = args.in[12]; const float* g_post_ffn = args.in[13];
    float* out = args.out;
    float* cosT = (float*)(ws + WS_COS); float* sinT = (float*)(ws + WS_SIN); float* LOGF = (float*)(ws + WS_LOGF); float* Fc = (float*)(ws + WS_F); float* LSE = (float*)(ws + WS_LSE);
    bf16* WIN_T = (bf16*)(ws + WS_WIN); bf16* WO_T = (bf16*)(ws + WS_WO); bf16* WOUT_T = (bf16*)(ws + WS_WOUT); bf16* WUP_T = (bf16*)(ws + WS_WUP); bf16* WDN_T = (bf16*)(ws + WS_WDN);
    bf16* QKV = (bf16*)(ws + WS_QKV); bf16* SGA = (bf16*)(ws + WS_SGA); bf16* SGB = (bf16*)(ws + WS_SGB); bf16* Hn = (bf16*)(ws + WS_H);
    bf16* OD = (bf16*)(ws + WS_OD); bf16* O2 = (bf16*)((unsigned char*)out + 32 * MiB);    bf16* H2 = (bf16*)(ws + WS_H2); bf16* MF = (bf16*)(ws + WS_M);
    bf16* MIXED = (bf16*)(ws + WS_MIXED);
    const int lo = args.ph_lo, hi_ph = args.ph_hi;
#define IN(k) (lo <= (k) && (k) < hi_ph)
    ((volatile LAS unsigned*)(lds + RING_BYTES))[tid & 63] = 0u;
    __syncthreads();
    XcdBarrier xbar; xbar.bar = (unsigned*)(ws + WS_BAR) + args.li * XCD_BAR_WORDS; xbar.x = 0; xbar.st = nullptr;
    if (args.coop == 1) xbar = xcd_barrier_post((unsigned*)(ws + WS_BAR) + args.li * XCD_BAR_WORDS, (volatile LAS unsigned*)(lds + RING_BYTES));
#define SEAM(k) do { if (IN(k) && IN((k) + 1)) { if (args.coop == 2) { __threadfence(); cg::this_grid().sync(); } else xcd_barrier(xbar); } } while (0)

    if (IN(0)) {
        LAS float* scr = (LAS float*)(lds + wave * 9216);
        LAS float* wfl = (LAS float*)(lds + 73728);
        for (int k = tid; k < D; k += NTHR) {
#pragma unroll
            for (int j = 0; j < 8; ++j) wfl[j * 1024 + k] = w_in[(size_t)k * INW + 1536 + j];
        }
        constexpr int I_IN = 16 * 160, I_OA = 8 * 32, I_OUT = 16 * 32, I_UP = 16 * 176, I_DN = 44 * 32;
        constexpr int NITEMS = I_IN + 2 * I_OA + I_OUT + I_UP + I_DN;
        for (int it = gw; it < I_IN; it += NGW) {
            int r = it;
            if (r < I_IN) { const int kb = r / 160, nb = r % 160, n0 = 32 * nb; p0_transpose_item(w_in, INW, 64 * kb, n0 + (n0 >= 1536 ? 8 : 0), WIN_T, D, n0, 64 * kb, scr, lane); continue; } r -= I_IN;
            if (r < I_OA) { const int kb = r / 32, nb = r % 32; p0_transpose_item(w_o_fox, D, 64 * kb, 32 * nb, WO_T, D, 32 * nb, 64 * kb, scr, lane); continue; } r -= I_OA;
            if (r < I_OA) { const int kb = r / 32, nb = r % 32; p0_transpose_item(w_o_dil, D, 64 * kb, 32 * nb, WO_T, D, 32 * nb, 512 + 64 * kb, scr, lane); continue; } r -= I_OA;
            if (r < I_OUT) { const int kb = r / 32, nb = r % 32; p0_transpose_item(w_out, D, 64 * kb, 32 * nb, WOUT_T, D, 32 * nb, 64 * kb, scr, lane); continue; } r -= I_OUT;
            if (r < I_UP) { const int kb = r / 176, nb = r % 176, n0 = 32 * nb, pn = n0 >> 8, i = n0 & 255; const int c0 = (i < 128) ? (128 * pn + i) : (FF + 128 * pn + i - 128);
                p0_transpose_item(w_up, NUP, 64 * kb, c0, WUP_T, D, n0, 64 * kb, scr, lane); continue; } r -= I_UP;
            { const int kb = r / 32, nb = r % 32; p0_transpose_item(w_down, D, 64 * kb, 32 * nb, WDN_T, FF, 32 * nb, 64 * kb, scr, lane); }
        }
        for (int id = bx * NTHR + tid; id < SEQ * 8; id += G * NTHR) {
            const int pos = id >> 3, i = id & 7;
            const double ang = (double)pos * args.invf[i];
            const double TWO_PI = 6.283185307179586476925286766559;
            const double kq = __builtin_rint(ang / TWO_PI);
            const double rr = (ang - kq * TWO_PI) * 0.25;
            const double r2 = rr * rr;
            double sn = rr * (1.0 + r2 * (-1.0 / 6 + r2 * (1.0 / 120 + r2 * (-1.0 / 5040 + r2 * (1.0 / 362880 + r2 * (-1.0 / 39916800 + r2 * (1.0 / 6227020800.0 + r2 * (-1.0 / 1307674368000.0))))))));
            double cs = 1.0 + r2 * (-0.5 + r2 * (1.0 / 24 + r2 * (-1.0 / 720 + r2 * (1.0 / 40320 + r2 * (-1.0 / 3628800 + r2 * (1.0 / 479001600 + r2 * (-1.0 / 87178291200.0 + r2 * (1.0 / 20922789888000.0))))))));
#pragma unroll
            for (int k2 = 0; k2 < 2; ++k2) { const double s2 = 2.0 * sn * cs, c2 = cs * cs - sn * sn; sn = s2; cs = c2; }
            cosT[id] = (float)cs; sinT[id] = (float)sn;
        }
        __syncthreads();
        {
            f32x4 wreg[8][4];
#pragma unroll
            for (int q = 0; q < 8; ++q)
#pragma unroll
                for (int j = 0; j < 4; ++j) wreg[q][j] = *((LAS const f32x4*)(wfl + q * 1024) + lane + 64 * j);
            f32x4 gg[4];
#pragma unroll
            for (int j = 0; j < 4; ++j) gg[j] = *((const f32x4*)g_pre_mix + lane + 64 * j);
            const float bfv = (lane < 8) ? b_forget[lane] : 0.f;
            f32x4 vn[4];
            if (gw < T) {
#pragma unroll
                for (int j = 0; j < 4; ++j) vn[j] = __builtin_nontemporal_load((const f32x4*)(x + (size_t)gw * D) + lane + 64 * j);
            }
            for (int m = gw; m < T; m += NGW) {
                f32x4 v[4]; float s = 0.f;
#pragma unroll
                for (int j = 0; j < 4; ++j) { v[j] = vn[j]; s += (v[j].x * v[j].x + v[j].y * v[j].y) + (v[j].z * v[j].z + v[j].w * v[j].w); }
                if (m + NGW < T) {
#pragma unroll
                    for (int j = 0; j < 4; ++j) vn[j] = __builtin_nontemporal_load((const f32x4*)(x + (size_t)(m + NGW) * D) + lane + 64 * j);
                }
                const float inv = 1.0f / sqrtf(wave_sum(s) * (1.0f / D) + RMS_EPS);
                float dot[8];
#pragma unroll
                for (int q = 0; q < 8; ++q) dot[q] = 0.f;
                unsigned long long* o8 = (unsigned long long*)(Hn + (size_t)m * D) + lane;
#pragma unroll
                for (int j = 0; j < 4; ++j) {
                    const f32x4 hv = v[j] * inv * gg[j];
                    o8[64 * j] = (unsigned long long)cvt_pk_bf16(hv.x, hv.y) | ((unsigned long long)cvt_pk_bf16(hv.z, hv.w) << 32);
#pragma unroll
                    for (int q = 0; q < 8; ++q) { const f32x4 wv = wreg[q][j]; dot[q] += (hv.x * wv.x + hv.y * wv.y) + (hv.z * wv.z + hv.w * wv.w); }
                }
#pragma unroll
                for (int q = 0; q < 8; ++q) dot[q] = wave_sum(dot[q]);
                float z = dot[0];
#pragma unroll
                for (int q = 1; q < 8; ++q) z = (lane == q) ? dot[q] : z;
                if (lane < 8) { z += bfv;
                    const float e = __expf(-fabsf(z)); LOGF[(size_t)m * 8 + lane] = fminf(z, 0.f) - log1pf(e); }
            }
        }
    }
    SEAM(0);

    if (IN(1)) {
        for (int bh = bx; bh < NB * NH; bh += G) {
            const int bb = bh >> 3, hh = bh & 7;
            const float* src = LOGF + ((size_t)bb * SEQ + 8 * tid) * 8 + hh;
            float v[8]; float sloc = 0.f;
#pragma unroll
            for (int i = 0; i < 8; ++i) { sloc += src[i * 8]; v[i] = sloc; }
            float incl = sloc;
#pragma unroll
            for (int o = 1; o < 64; o <<= 1) { const float t = __shfl_up(incl, o); if (lane >= o) incl += t; }
            LAS float* wt = (LAS float*)lds;
            if (lane == 63) wt[wave] = incl;
            __syncthreads();
            float off = 0.f;
            for (int w = 0; w < wave; ++w) off += wt[w];
            const float base = off + incl - sloc;
            float* dst = Fc + (size_t)bh * SEQ + 8 * tid;
            *(f32x4*)dst = (f32x4){base + v[0], base + v[1], base + v[2], base + v[3]};
            *(f32x4*)(dst + 4) = (f32x4){base + v[4], base + v[5], base + v[6], base + v[7]};
            __syncthreads();
        }
        pg8::Gemm g{Hn, WIN_T, D}; pg8::StaticOrder S; S.init(T / 256, NZ / 256, G, bx);
        pg8::EpiZ E{QKV, SGA, SGB, cosT, sinT, (unsigned*)(ws + WS_KH)};
        pg8::gemm_phase<pg8::EpiZ, pg8::StaticOrder>(lds, g, S, E);
    }
    SEAM(1);

    if (IN(2)) {
        const bf16* QBp = QKV + (size_t)3 * T * 512; const bf16* KBp = QKV + (size_t)4 * T * 512; const bf16* VBp = QKV + (size_t)5 * T * 512;
        dil_phase(lds, (G % 8 == 0) ? (bx & 7) * (G >> 3) + (bx >> 3) : bx, G, QBp, KBp, VBp, OD, LSE);
        const bf16* QAp = QKV; const bf16* KAp = QKV + (size_t)T * 512; const bf16* VAp = QKV + (size_t)2 * T * 512;
        { unsigned* qhead = (unsigned*)(ws + WS_FQ) + args.li; LAS int* qid = (LAS int*)(lds + 48128);
          for (;;) {
              if (tid == 0) qid[0] = (int)atomicAdd(qhead, 1u);
              __syncthreads();
              const int id = qid[0];
              if (id >= 512) break;
              const int bh = id & 31;
              fox_unit(lds, bh >> 3, bh & 7, 15 - (id >> 5), QAp, KAp, VAp, Fc, O2, (const unsigned*)(ws + WS_KH));
          }
        }
        {
            constexpr int I_OA = 8 * 32, I_OUT = 16 * 32, I_UP = 16 * 176, I_DN = 44 * 32;
            constexpr int NREST = 2 * I_OA + I_OUT + I_UP + I_DN;
            __syncthreads();
            LAS float* scr = (LAS float*)(lds + wave * 9216);
            unsigned* whead = (unsigned*)(ws + WS_FQ) + 32 + args.li; LAS int* wq = (LAS int*)(lds + 8 * 9216);
            for (;;) {
                if (tid == 0) wq[0] = (int)atomicAdd(whead, 1u);
                __syncthreads();
                const int it = wq[0] * 8 + wave;
                __syncthreads();
                if (it - wave >= NREST) break;
                if (it >= NREST) continue;
                int r = it;
                if (r < I_OA) { const int kb = r / 32, nb = r % 32; p0_transpose_item(w_o_fox, D, 64 * kb, 32 * nb, WO_T, D, 32 * nb, 64 * kb, scr, lane); continue; } r -= I_OA;
                if (r < I_OA) { const int kb = r / 32, nb = r % 32; p0_transpose_item(w_o_dil, D, 64 * kb, 32 * nb, WO_T, D, 32 * nb, 512 + 64 * kb, scr, lane); continue; } r -= I_OA;
                if (r < I_OUT) { const int kb = r / 32, nb = r % 32; p0_transpose_item(w_out, D, 64 * kb, 32 * nb, WOUT_T, D, 32 * nb, 64 * kb, scr, lane); continue; } r -= I_OUT;
                if (r < I_UP) { const int kb = r / 176, nb = r % 176, n0 = 32 * nb, pn = n0 >> 8, i = n0 & 255; const int c0 = (i < 128) ? (128 * pn + i) : (FF + 128 * pn + i - 128);
                    p0_transpose_item(w_up, NUP, 64 * kb, c0, WUP_T, D, n0, 64 * kb, scr, lane); continue; } r -= I_UP;
                { const int kb = r / 32, nb = r % 32; p0_transpose_item(w_down, D, 64 * kb, 32 * nb, WDN_T, FF, 32 * nb, 64 * kb, scr, lane); }
            }
        }
    }
    SEAM(2);

    if (IN(3)) {
        pg8::StaticOrder S; S.init(T / 256, D / 256, G, bx);
        { pg8::Unit mu;
          if (S.next(0, mu)) {
            unsigned* pcnt = (unsigned*)(ws + WS_MC) + 32 * mu.pm;
            const size_t rbase = (size_t)mu.pm * 256 + 64 * mu.pn;
            for (int it0 = tid; it0 < 64 * 64; it0 += 4 * NTHR) {
                float l0[4], l1[4], l2[4]; u32x4 a[4], b[4], cc[4];
#pragma unroll
                for (int q = 0; q < 4; ++q) { const int it = it0 + q * NTHR; const size_t row = rbase + (it >> 6); const int hh = (it >> 3) & 7, c = it & 7;
                    l0[q] = LSE[row * NH + hh]; l1[q] = LSE[((size_t)T + row) * NH + hh]; l2[q] = LSE[((size_t)2 * T + row) * NH + hh];
                    const size_t off = row * 512 + hh * 64 + c * 8;
                    a[q] = __builtin_nontemporal_load((const u32x4*)(OD + off)); b[q] = __builtin_nontemporal_load((const u32x4*)(OD + (size_t)T * 512 + off)); cc[q] = __builtin_nontemporal_load((const u32x4*)(OD + (size_t)2 * T * 512 + off)); }
#pragma unroll
                for (int q = 0; q < 4; ++q) { const int it = it0 + q * NTHR; const size_t row = rbase + (it >> 6); const int hh = (it >> 3) & 7, c = it & 7;
                    const float mx = fmaxf(l0[q], fmaxf(l1[q], l2[q]));
                    float w0 = __builtin_amdgcn_exp2f(l0[q] - mx), w1 = __builtin_amdgcn_exp2f(l1[q] - mx), w2 = __builtin_amdgcn_exp2f(l2[q] - mx);
                    const float inv = 1.0f / (w0 + w1 + w2); w0 *= inv; w1 *= inv; w2 *= inv;
                    u32x4 o;
                    o.x = cvt_pk_bf16(w0 * bf_lo(a[q].x) + w1 * bf_lo(b[q].x) + w2 * bf_lo(cc[q].x), w0 * bf_hi(a[q].x) + w1 * bf_hi(b[q].x) + w2 * bf_hi(cc[q].x));
                    o.y = cvt_pk_bf16(w0 * bf_lo(a[q].y) + w1 * bf_lo(b[q].y) + w2 * bf_lo(cc[q].y), w0 * bf_hi(a[q].y) + w1 * bf_hi(b[q].y) + w2 * bf_hi(cc[q].y));
                    o.z = cvt_pk_bf16(w0 * bf_lo(a[q].z) + w1 * bf_lo(b[q].z) + w2 * bf_lo(cc[q].z), w0 * bf_hi(a[q].z) + w1 * bf_hi(b[q].z) + w2 * bf_hi(cc[q].z));
                    o.w = cvt_pk_bf16(w0 * bf_lo(a[q].w) + w1 * bf_lo(b[q].w) + w2 * bf_lo(cc[q].w), w0 * bf_hi(a[q].w) + w1 * bf_hi(b[q].w) + w2 * bf_hi(cc[q].w));
                    st_wt16(O2 + row * 1024 + 512 + hh * 64 + c * 8, o); }
            }
            asm volatile("s_waitcnt vmcnt(0)" ::: "memory");
            __syncthreads();
            if (tid == 0) {
                __hip_atomic_fetch_add(pcnt, 1u, __ATOMIC_RELAXED, __HIP_MEMORY_SCOPE_AGENT);
                unsigned sp = 0;
                while (__hip_atomic_load(pcnt, __ATOMIC_RELAXED, __HIP_MEMORY_SCOPE_AGENT) < 4u) { __builtin_amdgcn_s_sleep(2); if (++sp > (1u << 22)) break; }
                __builtin_amdgcn_fence(__ATOMIC_ACQUIRE, "agent");
                asm volatile("s_waitcnt vmcnt(0)" ::: "memory");
            }
            __syncthreads();
          }
        }
        pg8::Gemm g{O2, WO_T, D};
        pg8::EpiMix E{SGA, SGB, MIXED};
        pg8::gemm_phase<pg8::EpiMix, pg8::StaticOrder>(lds, g, S, E);
    }
    SEAM(3);

    if (IN(4)) {
        pg8::Gemm g{MIXED, WOUT_T, D}; pg8::StaticOrder S; S.init(T / 256, D / 256, G, bx);
        pg8::PanelSS st1{(unsigned*)(ws + WS_XBUF), (unsigned*)(ws + WS_CNT)};
        pg8::PanelSS st2{(unsigned*)(ws + WS_XBUF + 0x40000), (unsigned*)(ws + WS_CNT + 0x4000)};
        pg8::EpiNormA E{x, out, H2, g_post_mix, g_pre_ffn, st1, st2};
        pg8::gemm_phase<pg8::EpiNormA, pg8::StaticOrder>(lds, g, S, E);
    }
    SEAM(4);

    if (IN(5)) {
        pg8::Gemm g{H2, WUP_T, D}; pg8::StaticOrder S; S.init(67, NUP / 256, G, bx);
        pg8::EpiConvGelu E{conv_w, conv_b, MF};
        pg8::gemm_phase<pg8::EpiConvGelu, pg8::StaticOrder>(lds, g, S, E);
    }
    SEAM(5);

    if (IN(6)) {
        pg8::Gemm g{MF, WDN_T, FF}; pg8::StaticOrder S; S.init(T / 256, D / 256, G, bx);
        pg8::PanelSS st{(unsigned*)(ws + WS_XBUF + 0x80000), (unsigned*)(ws + WS_CNT + 0x8000)};
        pg8::EpiNormB E{out, out, g_post_ffn, st};
        pg8::gemm_phase<pg8::EpiNormB, pg8::StaticOrder>(lds, g, S, E);
    }
#undef IN
#undef SEAM
}

#ifndef MK_N_LAUNCHES
#define MK_N_LAUNCHES 1
#endif
constexpr int NPHASES = 7;

extern "C" void kernel_launch(void* const* d_in, const int* in_sizes, int n_in, void* d_out, int out_size, void* d_ws, size_t ws_size, hipStream_t stream) {
    static int grid = 0;
    if (grid == 0) {
        if (n_in != 14 || in_sizes[0] != T * D || out_size != T * D || ws_size < WS_NEED) {
            fprintf(stderr, "kernel_launch: unexpected shapes: n_in %d in0 %d out %d ws %zu\n", n_in, n_in > 0 ? in_sizes[0] : -1, out_size, ws_size); grid = -1; return; }
        int dev = 0, cus = 0, per_cu = 0;
        if (hipGetDevice(&dev) != hipSuccess || hipDeviceGetAttribute(&cus, hipDeviceAttributeMultiprocessorCount, dev) != hipSuccess) { fprintf(stderr, "kernel_launch: device query failed\n"); grid = -1; return; }
        if (hipFuncSetAttribute((const void*)mega_fwd, hipFuncAttributeMaxDynamicSharedMemorySize, LDS_BYTES) != hipSuccess) { fprintf(stderr, "kernel_launch: hipFuncSetAttribute failed\n"); grid = -1; return; }
        if (hipOccupancyMaxActiveBlocksPerMultiprocessor(&per_cu, (const void*)mega_fwd, NTHR, LDS_BYTES) != hipSuccess || per_cu < 1) { fprintf(stderr, "kernel_launch: occupancy query says %d\n", per_cu); per_cu = 1; }
        (void)hipGetLastError();
        grid = cus * per_cu;
        if (grid > 256) grid = 256;
        if (grid != 256) fprintf(stderr, "kernel_launch: grid %d != 256: the fused RMSNorm epilogues need 256 co-resident workgroups\n", grid);
        fprintf(stderr, "kernel_launch: grid %d (cus %d x %d)\n", grid, cus, per_cu);
    }
    if (grid < 0) return;
    if (hipMemsetAsync(d_ws, 0, WS_BAR_BYTES, stream) != hipSuccess) { fprintf(stderr, "kernel_launch: memset failed\n"); return; }
    Args a{};
    for (int i = 0; i < 14; ++i) a.in[i] = (const float*)d_in[i];
    a.out = (float*)d_out; a.ws = (unsigned char*)d_ws;
    for (int i = 0; i < 8; ++i) a.invf[i] = pow(500000.0, -(double)i / 8.0);
    a.li = 0;
#if defined(PROBE_SPLIT)
    { void* params[] = {&a}; a.coop = 1;
      a.ph_lo = 0; a.ph_hi = PROBE_SPLIT + 1; hipLaunchCooperativeKernel((const void*)mega_fwd, dim3(grid), dim3(NTHR), params, LDS_BYTES, stream);
      a.li = 1; a.ph_lo = PROBE_SPLIT + 1; a.ph_hi = NPHASES; hipLaunchCooperativeKernel((const void*)mega_fwd, dim3(grid), dim3(NTHR), params, LDS_BYTES, stream); }
#elif defined(PROBE_DUP)
    { void* params[] = {&a}; a.coop = 1;
      a.ph_lo = 0; a.ph_hi = PROBE_DUP + 1; hipLaunchCooperativeKernel((const void*)mega_fwd, dim3(grid), dim3(NTHR), params, LDS_BYTES, stream);
      a.li = 1; a.ph_lo = PROBE_DUP; a.ph_hi = PROBE_DUP + 1; hipLaunchCooperativeKernel((const void*)mega_fwd, dim3(grid), dim3(NTHR), params, LDS_BYTES, stream);
      a.li = 2; a.ph_lo = PROBE_DUP + 1; a.ph_hi = NPHASES; hipLaunchCooperativeKernel((const void*)mega_fwd, dim3(grid), dim3(NTHR), params, LDS_BYTES, stream); }
#elif MK_N_LAUNCHES == 1
    a.ph_lo = 0; a.ph_hi = NPHASES; a.coop = 1;
    void* params[] = {&a};
    hipError_t e = hipLaunchCooperativeKernel((const void*)mega_fwd, dim3(grid), dim3(NTHR), params, LDS_BYTES, stream);
    if (e != hipSuccess) fprintf(stderr, "kernel_launch: cooperative launch failed: %s (grid %d)\n", hipGetErrorString(e), grid);
#else
    for (int p = 0; p < NPHASES; ++p) {
        a.ph_lo = p; a.ph_hi = p + 1; a.coop = 0;
        hipLaunchKernelGGL(mega_fwd, dim3(grid), dim3(NTHR), LDS_BYTES, stream, a);
    }
#endif
}
```
